# Optimizing an MI355X kernel written in HIP

```python
import jax, jax.numpy as jnp
from jax import lax
import numpy as np

D_MODEL = 2048
BATCH = 4
SEQ = 8192
DEPTH = 2

PLE_DIM = 256
POOL_GROUPS = 4
POOL_GROUP_W = 256
POOL_W = POOL_GROUPS * POOL_GROUP_W
POOL_WINDOWS = (2, 4, 8, 16)
SB_HEADS = 8
SB_HEAD_DIM = 128
SB_W = SB_HEADS * SB_HEAD_DIM
SB_BLOCK = 128
GLA_HEADS = 4
GLA_DK = 128
GLA_DV = 256
GLA_K_W = GLA_HEADS * GLA_DK
GLA_V_W = GLA_HEADS * GLA_DV
GLA_RANK = 16
GLA_TAU = 16.0
GLA_CHUNK = 64
IN_COLS = POOL_W + 3 * SB_W + 2 * GLA_K_W + GLA_V_W + GLA_RANK + GLA_V_W
N_BRANCH = 3
D_FF = 5632
N_EXPERTS = 8
TOP_K = 2
N_DENSE = (DEPTH + 1) // 2
N_MOE = DEPTH // 2
EPS = 1e-6

kernel_name = 'hybrid_pool_stickbreak_gla_moe_block'


def rmsnorm(x, g):
    xf = x.astype(jnp.float32)
    y = xf * lax.rsqrt(jnp.mean(xf * xf, axis=-1, keepdims=True) + EPS)
    return (y * g.astype(jnp.float32)).astype(x.dtype)


def swiglu(h, w1, w3, w2):
    return (jax.nn.silu(h @ w1) * (h @ w3)) @ w2


def pool_mixer(u, w_groups, scale):
    B, S, _ = u.shape
    ug = u.astype(jnp.float32).reshape(B, S, POOL_GROUPS, POOL_GROUP_W)
    cs = jnp.concatenate([jnp.zeros_like(ug[:, :1]), jnp.cumsum(ug, axis=1)], axis=1)
    t = jnp.arange(S)
    outs = []
    for gi, w in enumerate(POOL_WINDOWS):
        lo = jnp.maximum(t + 1 - w, 0)
        csg = cs[:, :, gi]
        win_sum = csg[:, 1:] - jnp.take(csg, lo, axis=1)
        count = jnp.minimum(t + 1, w).astype(jnp.float32)
        outs.append(win_sum / count[None, :, None] - ug[:, :, gi])
    pooled = jnp.stack(outs, axis=2).astype(u.dtype)
    mixed = jnp.einsum('bsgc,gcd->bsgd', pooled, w_groups)
    return mixed.reshape(B, S, POOL_W) * scale


def stick_breaking_attention(q, k, v):
    B, S, H, hd = q.shape
    qf = (q.astype(jnp.float32) * (hd ** -0.5)).transpose(0, 2, 1, 3)
    kf = k.astype(jnp.float32).transpose(0, 2, 1, 3)
    vf = v.astype(jnp.float32).transpose(0, 2, 1, 3)
    nb = S // SB_BLOCK
    qb = qf.reshape(B, H, nb, SB_BLOCK, hd).transpose(2, 0, 1, 3, 4)
    s_idx = jnp.arange(S)

    def block(args):
        q_blk, bi = args
        z = jnp.einsum('bhqd,bhsd->bhqs', q_blk, kf)
        t_idx = bi * SB_BLOCK + jnp.arange(SB_BLOCK)
        mask = s_idx[None, :] < t_idx[:, None]
        log_beta = jax.nn.log_sigmoid(z)
        log_keep = jnp.where(mask, jax.nn.log_sigmoid(-z), 0.0)
        later = lax.cumsum(log_keep, axis=3, reverse=True) - log_keep
        a = jnp.where(mask, jnp.exp(log_beta + later), 0.0)
        return jnp.einsum('bhqs,bhsd->bhqd', a, vf)

    out = lax.map(block, (qb, jnp.arange(nb)))
    return out.transpose(1, 0, 3, 2, 4).reshape(B, S, H * hd).astype(q.dtype)


def gla_mixer(q, k, v, log_a):
    B, S, H, dk = q.shape
    dv = v.shape[-1]
    n = S // GLA_CHUNK

    def chunks(t):
        return t.astype(jnp.float32).reshape(B, n, GLA_CHUNK, H, t.shape[-1]).transpose(1, 0, 3, 2, 4)

    qc = chunks(q) * (dk ** -0.5)
    kc, vc, lc = chunks(k), chunks(v), chunks(log_a)
    causal = jnp.tril(jnp.ones((GLA_CHUNK, GLA_CHUNK), dtype=bool))[None, None, :, :, None]

    def step(state, inp):
        qi, ki, vi, li = inp
        b = jnp.cumsum(li, axis=2)
        inter = jnp.einsum('bhtk,bhkv->bhtv', qi * jnp.exp(b), state)
        diff = b[:, :, :, None, :] - b[:, :, None, :, :]
        decay = jnp.where(causal, jnp.exp(jnp.where(causal, diff, 0.0)), 0.0)
        scores = jnp.einsum('bhtk,bhsk,bhtsk->bhts', qi, ki, decay)
        intra = jnp.einsum('bhts,bhsv->bhtv', scores, vi)
        b_end = b[:, :, -1:, :]
        new_state = jnp.exp(b_end[:, :, 0, :])[..., None] * state + jnp.einsum(
            'bhsk,bhsv->bhkv', ki * jnp.exp(b_end - b), vi)
        return new_state, inter + intra

    s0 = jnp.zeros((B, H, dk, dv), jnp.float32)
    _, out = lax.scan(step, s0, (qc, kc, vc, lc))
    return out.transpose(1, 0, 3, 2, 4).reshape(B, S, H, dv)


def moe_swiglu(h, router, w1, w3, w2):
    logits = (h @ router).astype(jnp.float32)
    vals, idx = lax.top_k(logits, TOP_K)
    wts = jax.nn.softmax(vals, axis=-1)
    comb = jnp.sum(jax.nn.one_hot(idx, N_EXPERTS, dtype=jnp.float32) * wts[..., None], axis=-2)
    comb = comb.astype(h.dtype)
    y = jnp.zeros_like(h)
    for e in range(N_EXPERTS):
        y = y + comb[..., e:e + 1] * swiglu(h, w1[e], w3[e], w2[e])
    return y


def setup_inputs(seed: int = 0) -> dict:
    key = jax.random.key(seed)
    ks = jax.random.split(key, 32)
    f32 = jnp.float32

    def nrm(k, shape, fan_in):
        return jax.random.normal(k, shape, f32) * (fan_in ** -0.5)

    def gain(k, shape):
        return 1.0 + 0.02 * jax.random.normal(k, shape, f32)

    return {
        'x': jax.random.normal(ks[0], (BATCH, SEQ, D_MODEL), f32),
        'p': jax.random.normal(ks[1], (DEPTH, BATCH, SEQ, PLE_DIM), f32),
        'g_mix': gain(ks[2], (DEPTH, D_MODEL)),
        'w_in': nrm(ks[3], (DEPTH, D_MODEL, IN_COLS), D_MODEL),
        'w_branch_gate': nrm(ks[4], (DEPTH, D_MODEL, N_BRANCH * D_MODEL), D_MODEL),
        'b_branch_gate': 0.02 * jax.random.normal(ks[5], (DEPTH, N_BRANCH * D_MODEL), f32),
        'pool_w': nrm(ks[6], (DEPTH, POOL_GROUPS, POOL_GROUP_W, POOL_GROUP_W), POOL_GROUP_W),
        'pool_scale': gain(ks[7], (DEPTH, POOL_W)),
        'sb_gq': gain(ks[8], (DEPTH, SB_HEAD_DIM)),
        'sb_gk': gain(ks[9], (DEPTH, SB_HEAD_DIM)),
        'gla_w_lr': nrm(ks[10], (DEPTH, GLA_RANK, GLA_K_W), GLA_RANK),
        'gla_b_lr': 0.02 * jax.random.normal(ks[11], (DEPTH, GLA_K_W), f32),
        'gla_g_out': gain(ks[12], (DEPTH, GLA_DV)),
        'w_up_pool': nrm(ks[13], (DEPTH, POOL_W, D_MODEL), POOL_W),
        'w_up_sb': nrm(ks[14], (DEPTH, SB_W, D_MODEL), SB_W),
        'w_up_gla': nrm(ks[15], (DEPTH, GLA_V_W, D_MODEL), GLA_V_W),
        'w_o': nrm(ks[16], (DEPTH, D_MODEL, D_MODEL), D_MODEL),
        'g_ffn': gain(ks[17], (DEPTH, D_MODEL)),
        'ffn_w1': nrm(ks[18], (N_DENSE, D_MODEL, D_FF), D_MODEL),
        'ffn_w3': nrm(ks[19], (N_DENSE, D_MODEL, D_FF), D_MODEL),
        'ffn_w2': nrm(ks[20], (N_DENSE, D_FF, D_MODEL), D_FF),
        'moe_router': nrm(ks[21], (N_MOE, D_MODEL, N_EXPERTS), D_MODEL),
        'moe_w1': nrm(ks[22], (N_MOE, N_EXPERTS, D_MODEL, D_FF), D_MODEL),
        'moe_w3': nrm(ks[23], (N_MOE, N_EXPERTS, D_MODEL, D_FF), D_MODEL),
        'moe_w2': nrm(ks[24], (N_MOE, N_EXPERTS, D_FF, D_MODEL), D_FF),
        'ple_w_proj': nrm(ks[25], (DEPTH, PLE_DIM, D_MODEL), PLE_DIM),
        'ple_w_gate': nrm(ks[26], (DEPTH, D_MODEL, D_MODEL), D_MODEL),
    }


def reference(x, p, g_mix, w_in, w_branch_gate, b_branch_gate, pool_w, pool_scale, sb_gq, sb_gk,
              gla_w_lr, gla_b_lr, gla_g_out, w_up_pool, w_up_sb, w_up_gla, w_o, g_ffn,
              ffn_w1, ffn_w3, ffn_w2, moe_router, moe_w1, moe_w3, moe_w2, ple_w_proj, ple_w_gate):
    B, S, _ = x.shape
    split_at = list(np.cumsum([POOL_W, SB_W, SB_W, SB_W, GLA_K_W, GLA_K_W, GLA_V_W, GLA_RANK]))
    for i in range(DEPTH):
        h = rmsnorm(x, g_mix[i])
        z = h @ w_in[i]
        u_pool, sq, sk, sv, gq, gk, gv, g_lr, g_r = jnp.split(z, split_at, axis=-1)

        y_pool = pool_mixer(u_pool, pool_w[i], pool_scale[i])

        sq = rmsnorm(sq.reshape(B, S, SB_HEADS, SB_HEAD_DIM), sb_gq[i])
        sk = rmsnorm(sk.reshape(B, S, SB_HEADS, SB_HEAD_DIM), sb_gk[i])
        y_sb = stick_breaking_attention(sq, sk, sv.reshape(B, S, SB_HEADS, SB_HEAD_DIM))

        gate_pre = (g_lr @ gla_w_lr[i] + gla_b_lr[i]).astype(jnp.float32)
        log_a = jax.nn.log_sigmoid(gate_pre) / GLA_TAU
        o_gla = gla_mixer(gq.reshape(B, S, GLA_HEADS, GLA_DK), gk.reshape(B, S, GLA_HEADS, GLA_DK),
                          gv.reshape(B, S, GLA_HEADS, GLA_DV), log_a.reshape(B, S, GLA_HEADS, GLA_DK))
        o_gla = rmsnorm(o_gla, gla_g_out[i]).reshape(B, S, GLA_V_W).astype(x.dtype)
        y_gla = o_gla * jax.nn.silu(g_r)

        gates = jax.nn.sigmoid(h @ w_branch_gate[i] + b_branch_gate[i])
        ga, gb, gc = jnp.split(gates, N_BRANCH, axis=-1)
        merged = ga * (y_pool @ w_up_pool[i]) + gb * (y_sb @ w_up_sb[i]) + gc * (y_gla @ w_up_gla[i])
        x = x + merged @ w_o[i]

        h2 = rmsnorm(x, g_ffn[i])
        j = i // 2
        if i % 2 == 0:
            x = x + swiglu(h2, ffn_w1[j], ffn_w3[j], ffn_w2[j])
        else:
            x = x + moe_swiglu(h2, moe_router[j], moe_w1[j], moe_w3[j], moe_w2[j])

        x = x + jax.nn.sigmoid(x @ ple_w_gate[i]) * (p[i] @ ple_w_proj[i])
    return x
```

```cpp
#include <hip/hip_runtime.h>
#include <cstdio>
#include <cstdint>

#ifndef MK_PER_PHASE
#define MK_PER_PHASE 0
#endif

#define LAS __attribute__((address_space(3)))
#define GAS __attribute__((address_space(1)))
typedef unsigned short bf16;
typedef short bf16x8 __attribute__((ext_vector_type(8)));
typedef float f32x2 __attribute__((ext_vector_type(2)));
typedef float f32x4 __attribute__((ext_vector_type(4)));
typedef float f32x16 __attribute__((ext_vector_type(16)));
typedef unsigned u32x2 __attribute__((ext_vector_type(2)));
typedef unsigned u32x4 __attribute__((ext_vector_type(4)));
typedef __bf16 bf16x2_t __attribute__((ext_vector_type(2)));

#define DI __device__ __forceinline__
DI unsigned pk2(float lo, float hi) { f32x2 v = {lo, hi}; bf16x2_t b = __builtin_convertvector(v, bf16x2_t); return __builtin_bit_cast(unsigned, b); }
DI float bflo(unsigned u) { return __uint_as_float(u << 16); }
DI float bfhi(unsigned u) { return __uint_as_float(u & 0xffff0000u); }
DI float bf2f(bf16 b) { return __uint_as_float(((unsigned)b) << 16); }
DI float fexp2(float x) { return __builtin_amdgcn_exp2f(x); }
DI float frcp(float x) { return __builtin_amdgcn_rcpf(x); }
DI float flog2(float x) { return __builtin_amdgcn_logf(x); }
DI float frsq(float x) { return __builtin_amdgcn_rsqf(x); }
constexpr float LOG2E = 1.4426950408889634f, LN2 = 0.6931471805599453f;
DI float fsigmoid(float x) { return frcp(1.0f + fexp2(-x * LOG2E)); }
DI float fsilu(float x) { return x * fsigmoid(x); }
DI float flogsigmoid(float x) { return fminf(x, 0.f) - LN2 * flog2(1.0f + fexp2(-fabsf(x) * LOG2E)); }
#define LDS_WAIT() asm volatile("s_waitcnt lgkmcnt(0)" ::: "memory")
#define VM_WAIT() asm volatile("s_waitcnt vmcnt(0)" ::: "memory")

constexpr int NB = 4, SEQ = 8192, T = NB * SEQ, D = 2048;
constexpr int IN_COLS = 7184;
constexpr int ZC = 7424, GC = 6144, NIN = ZC + GC;
constexpr int ZU = 0, ZSQ = 1024, ZSK = 2048, ZSV = 3072, ZGQ = 4096, ZGK = 4608, ZGV = 5120, ZGR = 6144, ZLR = 7168;
constexpr int DFF = 5632, NE = 8, PLE = 256;
constexpr float EPS = 1e-6f;
constexpr int NWAVES = 8, NTHR = 512;
constexpr int HALF_T = T / 2, SORT_ROWS = 34816, SORT_TILES = SORT_ROWS / 256;

constexpr size_t MiB = 1u << 20;
constexpr size_t WS_CTL = 0, CTL_ZERO_BYTES = 1 * MiB;
constexpr size_t WS_MISC = 1 * MiB;
constexpr size_t MISC_SEL = 0, MISC_SELW = 128 * 1024, MISC_SLOT = 384 * 1024, MISC_CNT = 640 * 1024, MISC_ROWW = 648 * 1024, MISC_TILE = 920 * 1024;
constexpr size_t WS_DBUF = 3 * MiB;
constexpr size_t WS_W = 4 * MiB;
constexpr size_t WL_WIN = 0, WL_POOL = 53 * MiB, WL_WUP = WL_POOL + MiB / 2, WL_WO = WL_WUP + 12 * MiB, WL_PLEP = WL_WO + 8 * MiB, WL_PLEG = WL_PLEP + 1 * MiB, WL_SIZE = WL_PLEG + 8 * MiB;
constexpr size_t WS_FFN13 = WS_W + 2 * WL_SIZE, WS_FFN2 = WS_FFN13 + 44 * MiB, WS_PB = WS_FFN2 + 22 * MiB;
constexpr size_t WS_HB = WS_PB + 32 * MiB;
constexpr size_t WS_PP = WS_HB + 128 * MiB;
constexpr size_t WS_BR = WS_PP + 128 * MiB;
constexpr size_t WS_Z = WS_BR, WS_GATES = WS_Z + 464 * MiB, WS_POOLED = WS_GATES + 384 * MiB, WS_SVT = WS_POOLED + 64 * MiB, WS_GVT = WS_SVT + 64 * MiB, WS_SBUF = WS_GVT + 64 * MiB;
constexpr size_t WS_ACT = WS_BR;
constexpr size_t WS_WMOE = WS_BR, WMOE_E = 66 * MiB, WMOE_W2 = 44 * MiB;
constexpr size_t WS_ASORT = WS_WMOE + 528 * MiB, WS_ACTS = WS_ASORT + 136 * MiB, WS_YSORT = WS_ACTS + 374 * MiB;
constexpr size_t WS_END = WS_YSORT + 136 * MiB;
static_assert(WL_SIZE == 82 * MiB + MiB / 2, "layer weight block");
static_assert(WS_SBUF + 128 * MiB <= WS_END, "mixer region inside the MoE region's extent");
static_assert((size_t)T * ZC * 2 == 464 * MiB && (size_t)T * GC * 2 == 384 * MiB && (size_t)SORT_ROWS * DFF * 2 <= 374 * MiB && (size_t)SORT_ROWS * D * 2 == 136 * MiB, "sizes");
constexpr int CW_TMO = 0, CW_BAR = 4096;

constexpr int RING_BYTES = 131072;
constexpr int MISC_OFF = RING_BYTES;
constexpr int LDS_BYTES = RING_BYTES + 1024;

namespace pg8 {
constexpr int BM = 256, BK = 64, HALF = 128, HTB = HALF * BK * 2, NXCD = 8, WGM = 8;
__host__ __device__ __forceinline__ int lds_byte(int r, int c) { const int st = (r >> 4) * 2 + (c >> 5), rr = r & 15, cc = c & 31, ob = rr * 64 + cc * 2; return st * 1024 + (ob ^ (((ob >> 9) & 1) << 5)); }
__host__ __device__ __forceinline__ void stage_rc(int b, int& R, int& C) { const int st = b / 1024, sb = b % 1024, swz = sb ^ (((sb >> 9) & 1) << 5); R = (st >> 1) * 16 + swz / 64; C = (st & 1) * 32 + (swz % 64) / 2; }
__host__ __device__ __forceinline__ int perm32(int rho) { const int n = rho >> 4, i = rho & 15; return 8 * (i >> 2) + 4 * n + (i & 3); }
struct Unit { int pm, pn, aux; };
struct StaticOrder {
    int nM, nN, nwg, G, c;
    __device__ void init(int nM_, int nN_, int G_, int c_) { nM = nM_; nN = nN_; nwg = nM * nN; G = G_; c = c_; }
    __device__ bool tile(int i, int& pm, int& pn) const {
        const long L = (long)i * G + c; if (L >= nwg) return false;
        int wgid = (int)L; { const int q = nwg / NXCD, r = nwg % NXCD, xcd = wgid % NXCD, off = wgid / NXCD; wgid = (xcd < r ? xcd * (q + 1) : r * (q + 1) + (xcd - r) * q) + off; }
        const int nig = WGM * nN, gid = wgid / nig, fm = gid * WGM, gsz = (nM - fm) < WGM ? (nM - fm) : WGM;
        pm = fm + ((wgid % nig) % gsz); pn = (wgid % nig) / gsz; return true;
    }
};
template <class P>
__device__ __forceinline__ void gemm_phase(LAS unsigned char* lds, const P& S) {
    int tid_ = threadIdx.x; asm volatile("" : "+v"(tid_));
    const int tid = tid_, wid = __builtin_amdgcn_readfirstlane(tid >> 6), lane = tid & 63, wr = wid >> 2, wc = wid & 3, fr = lane & 15, fq = lane >> 4;
    const int K = S.K, nt = K / BK;
    unsigned voffA[2], voffB[2];
#pragma unroll
    for (int i = 0; i < 2; ++i) { int R, C; stage_rc(tid * 16 + i * 8192, R, C); const int Rb = P::PERM ? ((R & ~31) + perm32(R & 31)) : R;
        voffA[i] = (unsigned)(R * S.lda + C) * 2u; voffB[i] = (unsigned)(Rb * S.ldb + C) * 2u; }
    const size_t kstep = (size_t)(BK * 2);
    const size_t hstepA = (size_t)HALF * S.lda * 2, hstepB = (size_t)HALF * S.ldb * 2;
    const unsigned ldsw = (unsigned)wid * 1024u;
    const int aoff = lds_byte(wr * 64 + fr, fq * 8), boff = lds_byte(wc * 32 + fr, fq * 8);
#define PG8_SA(b, h) (((b) * 2 + (h)) * HTB)
#define PG8_SB(b, h) ((4 + (b) * 2 + (h)) * HTB)
#define PG8_STAGE(bufoff, gbase, voff) do { _Pragma("unroll") for (int _i = 0; _i < 2; ++_i) \
        __builtin_amdgcn_global_load_lds((const unsigned*)((const char*)(gbase) + (voff)[_i]), (LAS unsigned*)(lds + (bufoff) + ldsw + _i * 8192), 16, 0, 0); } while (0)
#define PG8_LDA(dst, b, h) do { _Pragma("unroll") for (int m = 0; m < 4; ++m) _Pragma("unroll") for (int k = 0; k < 2; ++k) dst[m][k] = *(const LAS bf16x8*)(lds + PG8_SA(b, h) + aoff + m * 2048 + k * 1024); } while (0)
#define PG8_LDB(dst, b, h) do { _Pragma("unroll") for (int n = 0; n < 2; ++n) _Pragma("unroll") for (int k = 0; k < 2; ++k) dst[n][k] = *(const LAS bf16x8*)(lds + PG8_SB(b, h) + boff + n * 2048 + k * 1024); } while (0)
#define PG8_MMA(ai, bj, At, Bt) do { __builtin_amdgcn_s_setprio(1); _Pragma("unroll") for (int m = 0; m < 4; ++m) _Pragma("unroll") for (int n = 0; n < 2; ++n) _Pragma("unroll") for (int k = 0; k < 2; ++k) \
        acc[ai][bj][m][n] = __builtin_amdgcn_mfma_f32_16x16x32_bf16(Bt[n][k], At[m][k], acc[ai][bj][m][n], 0, 0, 0); __builtin_amdgcn_s_setprio(0); } while (0)
#define PG8_WAIT_V(n) asm volatile("s_waitcnt vmcnt(" #n ")" ::: "memory")
#define PG8_WAIT_L(n) asm volatile("s_waitcnt lgkmcnt(" #n ")" ::: "memory")
#define PG8_BAR __builtin_amdgcn_s_barrier()
#define PG8_SCHED __builtin_amdgcn_sched_barrier(0)
    Unit cur, nxt; int ui = 0;
    if (!S.next(0, cur)) return;
    f32x4 acc[2][2][4][2];
#pragma unroll
    for (int a = 0; a < 2; ++a)
#pragma unroll
        for (int b = 0; b < 2; ++b)
#pragma unroll
            for (int m = 0; m < 4; ++m)
#pragma unroll
                for (int n = 0; n < 2; ++n) acc[a][b][m][n] = (f32x4){0.f, 0.f, 0.f, 0.f};
    bf16x8 At[4][2], B0[2][2], B1[2][2];
    const char* cA = S.a_base(cur); const char* cB = S.b_base(cur);
    PG8_STAGE(PG8_SB(0, 0), cB, voffB); PG8_STAGE(PG8_SB(0, 1), cB + hstepB, voffB); PG8_STAGE(PG8_SA(0, 0), cA, voffA); PG8_STAGE(PG8_SA(0, 1), cA + hstepA, voffA);
    if (wr == 1) PG8_BAR;
    PG8_WAIT_V(2); PG8_BAR;
    PG8_STAGE(PG8_SB(1, 0), cB + kstep, voffB); PG8_STAGE(PG8_SA(1, 0), cA + kstep, voffA); PG8_STAGE(PG8_SB(1, 1), cB + hstepB + kstep, voffB);
    PG8_WAIT_V(6); PG8_BAR;
    for (;;) {
        const bool has_next = S.next(ui + 1, nxt);
        const char* nA = has_next ? S.a_base(nxt) : cA; const char* nB = has_next ? S.b_base(nxt) : cB;
        for (int t = 0; t < nt; t += 2) {
            const bool last = (t == nt - 2);
            const char* a1 = cA + (size_t)(t + 1) * kstep;
            const char* a2 = last ? nA : cA + (size_t)(t + 2) * kstep; const char* b2 = last ? nB : cB + (size_t)(t + 2) * kstep;
            const char* a3 = a2 + kstep; const char* b3 = b2 + kstep;
            PG8_LDB(B0, 0, 0); PG8_LDB(B1, 0, 1); PG8_SCHED; PG8_LDA(At, 0, 0); PG8_STAGE(PG8_SA(1, 1), a1 + hstepA, voffA);
            PG8_WAIT_V(8); PG8_WAIT_L(0); PG8_BAR; PG8_MMA(0, 0, At, B0); PG8_MMA(0, 1, At, B1); PG8_BAR; PG8_SCHED;
            PG8_LDA(At, 0, 1); PG8_STAGE(PG8_SB(0, 0), b2, voffB); PG8_STAGE(PG8_SB(0, 1), b2 + hstepB, voffB); PG8_STAGE(PG8_SA(0, 0), a2, voffA);
            PG8_WAIT_V(8); PG8_WAIT_L(0); PG8_BAR; PG8_MMA(1, 0, At, B0); PG8_MMA(1, 1, At, B1); PG8_BAR; PG8_SCHED;
            PG8_LDB(B0, 1, 0); PG8_LDB(B1, 1, 1); PG8_SCHED; PG8_LDA(At, 1, 0); PG8_STAGE(PG8_SA(0, 1), a2 + hstepA, voffA);
            PG8_WAIT_V(8); PG8_WAIT_L(0); PG8_BAR; PG8_MMA(0, 0, At, B0); PG8_MMA(0, 1, At, B1); PG8_BAR; PG8_SCHED;
            PG8_LDA(At, 1, 1); PG8_STAGE(PG8_SB(1, 0), b3, voffB); PG8_STAGE(PG8_SB(1, 1), b3 + hstepB, voffB); PG8_STAGE(PG8_SA(1, 0), a3, voffA);
            PG8_WAIT_V(8); PG8_WAIT_L(0); PG8_BAR; PG8_MMA(1, 0, At, B0); PG8_MMA(1, 1, At, B1); PG8_BAR; PG8_SCHED;
        }
        if (wr == 0) PG8_BAR;
        const bool zero = S.epi(acc, cur, wr, wc, fr, fq);
        if (!has_next) break;
        if (zero) {
#pragma unroll
        for (int a = 0; a < 2; ++a)
#pragma unroll
            for (int b = 0; b < 2; ++b)
#pragma unroll
                for (int m = 0; m < 4; ++m)
#pragma unroll
                    for (int n = 0; n < 2; ++n) acc[a][b][m][n] = (f32x4){0.f, 0.f, 0.f, 0.f};
        }
        cur = nxt; cA = nA; cB = nB; ++ui;
        if (wr == 1) PG8_BAR;
    }
    PG8_WAIT_V(0);
    PG8_BAR;
#undef PG8_SA
#undef PG8_SB
#undef PG8_STAGE
#undef PG8_LDA
#undef PG8_LDB
#undef PG8_MMA
#undef PG8_WAIT_V
#undef PG8_WAIT_L
#undef PG8_BAR
#undef PG8_SCHED
}
}

#define XB_TMO      128
#define XB_XCNT(j)  (256  + 64 * (j))
#define XB_XSUB(j)  (1280 + 64 * (j))
#define XB_XGEN(j)  (2304 + 64 * (j))
#define XB_TOP      3328
#define XB_TOPGEN   3392
#define XCD_BAR_WORDS 3456
#define XB_SPIN_CAP (1u << 20)
__device__ __forceinline__ unsigned xb_ld(unsigned* p)              { return __hip_atomic_load(p, __ATOMIC_RELAXED, __HIP_MEMORY_SCOPE_AGENT); }
__device__ __forceinline__ unsigned xb_add(unsigned* p, unsigned v) { return __hip_atomic_fetch_add(p, v, __ATOMIC_RELAXED, __HIP_MEMORY_SCOPE_AGENT); }
__device__ __forceinline__ unsigned xb_xcc_id() { return (unsigned)__builtin_amdgcn_s_getreg((3 << 11) | 20) & 0xFu; }
#define XB_SPIN(cond, bar) do { unsigned _sp = 0; while (cond) { __builtin_amdgcn_s_sleep(1); \
    if ((++_sp & 255u) == 0u) { if (xb_ld(&(bar)[XB_TMO])) break; if (_sp > XB_SPIN_CAP) { atomicAdd(&(bar)[XB_TMO], 1u); break; } } } } while (0)
struct XcdBarrier { unsigned* bar; unsigned x; volatile LAS unsigned* st; };
__device__ __forceinline__ XcdBarrier xcd_barrier_post(unsigned* bar, volatile LAS unsigned* st) {
    XcdBarrier b; b.bar = bar; b.x = xb_xcc_id(); b.st = st;
    if (threadIdx.x == 0) (void)xb_add(&bar[XB_XCNT(b.x)], 1u);
    return b;
}
__device__ __forceinline__ void xcd_barrier_complete(unsigned* bar, unsigned x, unsigned& nloc, unsigned& nx) {
    const unsigned G = gridDim.x * gridDim.y * gridDim.z;
    unsigned sum, cnt, mine, sp = 0u;
    for (;;) {
        sum = 0u; cnt = 0u; mine = 0u;
#pragma unroll
        for (unsigned j = 0; j < 16; ++j) { const unsigned c = xb_ld(&bar[XB_XCNT(j)]); sum += c; cnt += (c > 0u) ? 1u : 0u; mine = (j == x) ? c : mine; }
        if (sum == G) break;
        __builtin_amdgcn_s_sleep(1);
        if ((++sp & 255u) == 0u) { if (xb_ld(&bar[XB_TMO])) break; if (sp > XB_SPIN_CAP) { atomicAdd(&bar[XB_TMO], 1u); break; } }
    }
    nloc = mine > 0u ? mine : 1u; nx = cnt > 0u ? cnt : 1u;
}
__device__ __forceinline__ void xcd_barrier(const XcdBarrier& b) {
    asm volatile("s_waitcnt vmcnt(0)" ::: "memory");
    __syncthreads();
    if (threadIdx.x == 0) {
        unsigned* bar = b.bar;
        __builtin_amdgcn_s_waitcnt(0);
        unsigned nloc = b.st[0], nx = b.st[1];
        if (nloc == 0u) { xcd_barrier_complete(bar, b.x, nloc, nx); b.st[0] = nloc; b.st[1] = nx; }
        const unsigned old = xb_add(&bar[XB_XSUB(b.x)], 1u);
        const unsigned gen = old / nloc;
        if (old + 1u == (gen + 1u) * nloc) {
            __builtin_amdgcn_fence(__ATOMIC_RELEASE, "agent");
            asm volatile("s_waitcnt vmcnt(0)" ::: "memory");
            const unsigned og = xb_add(&bar[XB_TOP], 1u);
            const unsigned tg = og / nx;
            if (og + 1u == (tg + 1u) * nx) xb_add(&bar[XB_TOPGEN], 1u);
            else XB_SPIN(xb_ld(&bar[XB_TOPGEN]) == tg, bar);
            __builtin_amdgcn_fence(__ATOMIC_ACQUIRE, "agent");
            xb_add(&bar[XB_XGEN(b.x)], 1u);
            asm volatile("s_waitcnt vmcnt(0)" ::: "memory");
        } else {
            XB_SPIN(xb_ld(&bar[XB_XGEN(b.x)]) == gen, bar);
            __builtin_amdgcn_fence(__ATOMIC_ACQUIRE, "agent");
            asm volatile("s_waitcnt vmcnt(0)" ::: "memory");
        }
    }
    __syncthreads();
}

struct Args { const float* in[27]; float* out; unsigned char* ws; int ph_lo, ph_hi; };
enum { I_X = 0, I_P, I_GMIX, I_WIN, I_WBG, I_BBG, I_POOLW, I_POOLS, I_SBGQ, I_SBGK, I_GLAWLR, I_GLABLR, I_GLAGOUT, I_WUPP, I_WUPS, I_WUPG, I_WO, I_GFFN,
       I_FW1, I_FW3, I_FW2, I_ROUTER, I_MW1, I_MW3, I_MW2, I_PLEP, I_PLEG };
struct Frame {
    LAS unsigned char* lds;
    int tid, lane, wave, G, vcu, gw, ngw;
};
DI Frame fresh(const Frame& F0) {
    Frame F = F0; int t = F0.tid; asm volatile("" : "+v"(t)); F.tid = t; F.lane = t & 63; F.wave = __builtin_amdgcn_readfirstlane(t >> 6); F.gw = F.vcu * NWAVES + F.wave; return F;
}
DI float wave_sum(float v) {
#pragma unroll
    for (int o = 1; o < 64; o <<= 1) v += __shfl_xor(v, o);
    return v;
}

DI int map_row(int kind, int n, int row_off) {
    if (kind == 1) return n < 6144 ? n : (n < 6160 ? ZLR + (n - 6144) : ZGR + (n - 6160));
    if (kind == 2) return (n >> 7) * 256 + (n & 127);
    if (kind == 3) return (n >> 7) * 256 + 128 + (n & 127);
    return n + row_off;
}
DI void transpose_item(const float* __restrict__ W, int K, int N, bf16* WT, int kind, int row_off, LAS float* scr, int item, int lane) {
    const int nblk = (N + 31) / 32, kb = item / nblk, nb = item % nblk, k0 = 64 * kb, n0 = 32 * nb;
    const int nr = n0 + (lane & 31);
#pragma unroll 8
    for (int i = 0; i < 32; ++i) { const int kk = 2 * i + (lane >> 5); scr[kk * 33 + (lane & 31)] = nr < N ? W[(size_t)(k0 + kk) * N + nr] : 0.f; }
    LDS_WAIT(); asm volatile("" ::: "memory");
    const int c = lane & 7;
#pragma unroll
    for (int j = 0; j < 4; ++j) { const int nl = (lane >> 3) + 8 * j; const LAS float* s = scr + (8 * c) * 33 + nl;
        u32x4 o; o.x = pk2(s[0 * 33], s[1 * 33]); o.y = pk2(s[2 * 33], s[3 * 33]); o.z = pk2(s[4 * 33], s[5 * 33]); o.w = pk2(s[6 * 33], s[7 * 33]);
        if (n0 + nl < N) *(u32x4*)(WT + (size_t)map_row(kind, n0 + nl, row_off) * K + k0 + 8 * c) = o; }
    LDS_WAIT(); asm volatile("" ::: "memory");
}
DI void convert_matrix(const Frame& F0, const float* W, int K, int N, bf16* WT, int kind, int row_off, int rot) {
    const Frame F = fresh(F0);
    LAS float* scr = (LAS float*)(F.lds + F.wave * 16384);
    const int nitems = (K / 64) * ((N + 31) / 32);
    int g0 = F.gw - (rot % F.ngw); if (g0 < 0) g0 += F.ngw;
    for (int it = g0; it < nitems; it += F.ngw) transpose_item(W, K, N, WT, kind, row_off, scr, it, F.lane);
}

DI void rms_row(const float* xrow, const float* g, bf16* hrow, float* xcopy, int lane, f32x4 (&v)[8], float& rstd) {
    const f32x4* xr = (const f32x4*)xrow + lane; float ss = 0.f;
#pragma unroll
    for (int j = 0; j < 8; ++j) { v[j] = xr[64 * j]; ss += (v[j].x * v[j].x + v[j].y * v[j].y) + (v[j].z * v[j].z + v[j].w * v[j].w); }
    rstd = frsq(wave_sum(ss) * (1.f / D) + EPS);
    u32x2* o8 = (u32x2*)hrow + lane;
#pragma unroll
    for (int j = 0; j < 8; ++j) { const f32x4 gg = ((const f32x4*)g)[lane + 64 * j]; if (xcopy) ((f32x4*)xcopy)[lane + 64 * j] = v[j];
        v[j] = v[j] * rstd * gg; u32x2 w; w.x = pk2(v[j].x, v[j].y); w.y = pk2(v[j].z, v[j].w); o8[64 * j] = w; }
}
DI void phase_rmsnorm(const Frame& F0, const float* X, const float* g, bf16* HB, float* xcopy) {
    const Frame F = fresh(F0);
    for (int m = F.gw; m < T; m += F.ngw) { f32x4 v[8]; float rstd; rms_row(X + (size_t)m * D, g, HB + (size_t)m * D, xcopy ? xcopy + (size_t)m * D : nullptr, F.lane, v, rstd); }
}
DI void phase_rmsnorm_route(const Frame& F0, const float* X, const float* g, bf16* HB, const float* router, int* sel, float* selw, int* cnt) {
    const Frame F = fresh(F0);
    LAS float* rl = (LAS float*)F.lds;
    LAS int* sl = (LAS int*)(F.lds + 65536);
    for (int i = F.tid; i < D * NE / 4; i += NTHR) ((LAS f32x4*)rl)[i] = ((const f32x4*)router)[i];
    __syncthreads();
    const int c = blockIdx.x;
    for (int i = 0; i < 16; ++i) {
        const int lr = F.wave * 16 + i, m = c * 128 + lr;
        f32x4 v[8]; float rstd; rms_row(X + (size_t)m * D, g, HB + (size_t)m * D, nullptr, F.lane, v, rstd);
        float lg[NE];
#pragma unroll
        for (int e = 0; e < NE; ++e) lg[e] = 0.f;
#pragma unroll
        for (int j = 0; j < 8; ++j) {
#pragma unroll
            for (int q = 0; q < 4; ++q) { const int col = 4 * F.lane + 256 * j + q; const f32x4 r0 = *(const LAS f32x4*)(rl + col * 8), r1 = *(const LAS f32x4*)(rl + col * 8 + 4); const float hv = v[j][q];
                lg[0] += hv * r0.x; lg[1] += hv * r0.y; lg[2] += hv * r0.z; lg[3] += hv * r0.w; lg[4] += hv * r1.x; lg[5] += hv * r1.y; lg[6] += hv * r1.z; lg[7] += hv * r1.w; } }
#pragma unroll
        for (int e = 0; e < NE; ++e) lg[e] = wave_sum(lg[e]);
        int e1 = 0; float v1 = lg[0];
#pragma unroll
        for (int e = 1; e < NE; ++e) if (lg[e] > v1) { v1 = lg[e]; e1 = e; }
        int e2 = -1; float v2 = -3.0e38f;
#pragma unroll
        for (int e = 0; e < NE; ++e) if (e != e1 && lg[e] > v2) { v2 = lg[e]; e2 = e; }
        const float w1 = frcp(1.0f + fexp2((v2 - v1) * LOG2E)), w2 = 1.0f - w1;
        if (F.lane == 0) { sel[m] = e1 | (e2 << 8); selw[2 * m] = w1; selw[2 * m + 1] = w2; sl[lr] = e1 | (e2 << 8); }
    }
    __syncthreads();
    if (F.tid < NE) { int n = 0; for (int i = 0; i < 128; ++i) { const int s = sl[i]; n += ((s & 255) == F.tid) + ((s >> 8) == F.tid); } cnt[c * NE + F.tid] = n; }
    __syncthreads();
}

DI void phase_postproj(const Frame& F0, bf16* Z, const float* gq, const float* gk, bf16* POOLED, bf16* SVT, bf16* GVT) {
    const Frame F = fresh(F0);
    for (int m = F.gw; m < T; m += F.ngw) {
        u32x4* row = (u32x4*)(Z + (size_t)m * ZC + ZSQ);
#pragma unroll
        for (int j = 0; j < 4; ++j) {
            const int ch = F.lane + 64 * j; u32x4 w = row[ch];
            float f[8] = {bflo(w.x), bfhi(w.x), bflo(w.y), bfhi(w.y), bflo(w.z), bfhi(w.z), bflo(w.w), bfhi(w.w)};
            float ss = 0.f;
#pragma unroll
            for (int q = 0; q < 8; ++q) ss += f[q] * f[q];
            ss += __shfl_xor(ss, 1); ss += __shfl_xor(ss, 2); ss += __shfl_xor(ss, 4); ss += __shfl_xor(ss, 8);
            float sc = frsq(ss * (1.f / 128.f) + EPS); if (j < 2) sc *= 0.08838834764831845f * LOG2E;
            const float* gg = (j < 2 ? gq : gk) + (ch & 15) * 8;
            const f32x4 g0 = *(const f32x4*)gg, g1 = *(const f32x4*)(gg + 4);
            w.x = pk2(f[0] * sc * g0.x, f[1] * sc * g0.y); w.y = pk2(f[2] * sc * g0.z, f[3] * sc * g0.w); w.z = pk2(f[4] * sc * g1.x, f[5] * sc * g1.y); w.w = pk2(f[6] * sc * g1.z, f[7] * sc * g1.w);
            row[ch] = w;
        }
    }
    for (int it = F.gw * 64 + F.lane; it < (T / 16) * 128; it += F.ngw * 64) {
        const int tile = it >> 7, ch = it & 127, c0 = ch * 8, g = c0 >> 8, w = 2 << g, t0 = tile * 16, s0 = t0 & (SEQ - 1);
        float win[8];
#pragma unroll
        for (int q = 0; q < 8; ++q) win[q] = 0.f;
        for (int j = 1; j < w; ++j) { if (s0 - j >= 0) { const u32x4 u = *(const u32x4*)(Z + (size_t)(t0 - j) * ZC + ZU + c0);
                win[0] += bflo(u.x); win[1] += bfhi(u.x); win[2] += bflo(u.y); win[3] += bfhi(u.y); win[4] += bflo(u.z); win[5] += bfhi(u.z); win[6] += bflo(u.w); win[7] += bfhi(u.w); } }
        for (int i = 0; i < 16; ++i) {
            const int s = s0 + i; const u32x4 u = *(const u32x4*)(Z + (size_t)(t0 + i) * ZC + ZU + c0);
            const float f[8] = {bflo(u.x), bfhi(u.x), bflo(u.y), bfhi(u.y), bflo(u.z), bfhi(u.z), bflo(u.w), bfhi(u.w)};
#pragma unroll
            for (int q = 0; q < 8; ++q) win[q] += f[q];
            const float inv = 1.0f / (float)(s + 1 < w ? s + 1 : w);
            u32x4 o; o.x = pk2(win[0] * inv - f[0], win[1] * inv - f[1]); o.y = pk2(win[2] * inv - f[2], win[3] * inv - f[3]); o.z = pk2(win[4] * inv - f[4], win[5] * inv - f[5]); o.w = pk2(win[6] * inv - f[6], win[7] * inv - f[7]);
            *(u32x4*)(POOLED + (size_t)(t0 + i) * 1024 + c0) = o;
            if (s - w + 1 >= 0) { const u32x4 d = *(const u32x4*)(Z + (size_t)(t0 + i - w + 1) * ZC + ZU + c0);
                win[0] -= bflo(d.x); win[1] -= bfhi(d.x); win[2] -= bflo(d.y); win[3] -= bfhi(d.y); win[4] -= bflo(d.z); win[5] -= bfhi(d.z); win[6] -= bflo(d.w); win[7] -= bfhi(d.w); }
        }
    }
    LAS bf16* scr = (LAS bf16*)(F.lds + F.wave * 9216);
    for (int it = F.gw; it < 2 * (T / 64) * 16; it += F.ngw) {
        const int which = it / ((T / 64) * 16), r = it % ((T / 64) * 16), tt = r >> 4, cb = r & 15, t0 = tt * 64, c0 = cb * 64;
        const bf16* src = Z + (size_t)t0 * ZC + (which ? ZGV : ZSV) + c0; bf16* dst = which ? GVT : SVT;
#pragma unroll
        for (int j = 0; j < 8; ++j) { const int idx = F.lane + 64 * j, tok = idx >> 3, cc = (idx & 7) * 8; const u32x4 u = *(const u32x4*)(src + (size_t)tok * ZC + cc);
            const unsigned uu[4] = {u.x, u.y, u.z, u.w};
#pragma unroll
            for (int q = 0; q < 4; ++q) { scr[(cc + 2 * q) * 72 + tok] = (bf16)(uu[q] & 0xffffu); scr[(cc + 2 * q + 1) * 72 + tok] = (bf16)(uu[q] >> 16); } }
        LDS_WAIT(); asm volatile("" ::: "memory");
        const int b = t0 / SEQ, s0 = t0 % SEQ;
#pragma unroll
        for (int j = 0; j < 8; ++j) { const int idx = F.lane + 64 * j, chn = idx >> 3, tk = (idx & 7) * 8; const u32x4 u = *(const LAS u32x4*)(scr + chn * 72 + tk);
            *(u32x4*)(dst + ((size_t)(b * 1024 + c0 + chn)) * SEQ + s0 + tk) = u; }
        LDS_WAIT(); asm volatile("" ::: "memory");
    }
}

DI void phase_sb(const Frame& F0, bf16* Z, const bf16* SVT) {
    const Frame F = fresh(F0);
    const int lane = F.lane, tq = lane & 31, hh = lane >> 5;
    const int pi = 16 * ((tq >> 2) & 1) + 4 * (tq >> 3) + (tq & 3);
    for (int u = blockIdx.x; u < NB * 8 * (SEQ / 256); u += F.G) {
        const int qb = u & 31, bh = u >> 5, b = bh >> 3, h = bh & 7;
        const int t0 = qb * 256 + F.wave * 32;
        const size_t rowbase = (size_t)b * SEQ;
        bf16x8 qf[8];
        { const bf16* qp = Z + (rowbase + t0 + tq) * ZC + ZSQ + h * 128 + hh * 8;
#pragma unroll
          for (int kk = 0; kk < 8; ++kk) qf[kk] = *(const bf16x8*)(qp + kk * 16); }
        f32x16 o[4];
#pragma unroll
        for (int db = 0; db < 4; ++db)
#pragma unroll
            for (int r = 0; r < 16; ++r) o[db][r] = 0.f;
        float R = 1.f;
        const bf16* vbase = SVT + ((size_t)(b * 1024 + h * 128 + tq)) * SEQ + 16 * hh;
        for (int s0 = t0; s0 >= 0; s0 -= 32) {
            const bf16* kp = Z + (rowbase + s0 + pi) * ZC + ZSK + h * 128 + hh * 8;
            bf16x8 kf[8];
#pragma unroll
            for (int kk = 0; kk < 8; ++kk) kf[kk] = *(const bf16x8*)(kp + kk * 16);
            bf16x8 vf[4][2];
#pragma unroll
            for (int db = 0; db < 4; ++db)
#pragma unroll
                for (int j = 0; j < 2; ++j) vf[db][j] = *(const bf16x8*)(vbase + (size_t)db * 32 * SEQ + s0 + 8 * j);
            f32x16 s;
#pragma unroll
            for (int r = 0; r < 16; ++r) s[r] = 0.f;
#pragma unroll
            for (int kk = 0; kk < 8; ++kk) s = __builtin_amdgcn_mfma_f32_32x32x16_bf16(kf[kk], qf[kk], s, 0, 0, 0);
            const bool diag = (s0 == t0);
            float p[16]; float run = 1.f;
#pragma unroll
            for (int r = 15; r >= 0; --r) {
                const float e = fexp2(s[r]); float keep = frcp(1.0f + e), beta = 1.0f - keep;
                if (diag && (16 * hh + r >= tq)) { keep = 1.0f; beta = 0.f; }
                p[r] = beta * run; run *= keep;
            }
            const float other = __shfl_xor(run, 32);
            const float pref = hh ? R : R * other;
            R = R * run * other;
            bf16x8 pb[2];
#pragma unroll
            for (int j = 0; j < 2; ++j) { u32x4 w; w.x = pk2(p[8 * j] * pref, p[8 * j + 1] * pref); w.y = pk2(p[8 * j + 2] * pref, p[8 * j + 3] * pref); w.z = pk2(p[8 * j + 4] * pref, p[8 * j + 5] * pref); w.w = pk2(p[8 * j + 6] * pref, p[8 * j + 7] * pref);
                pb[j] = __builtin_bit_cast(bf16x8, w); }
#pragma unroll
            for (int db = 0; db < 4; ++db)
#pragma unroll
                for (int j = 0; j < 2; ++j) o[db] = __builtin_amdgcn_mfma_f32_32x32x16_bf16(vf[db][j], pb[j], o[db], 0, 0, 0);
            if (__all(R < 7.8e-31f)) break;
        }
        bf16* op = Z + (rowbase + t0 + tq) * ZC + ZSQ + h * 128 + 4 * hh;
#pragma unroll
        for (int db = 0; db < 4; ++db)
#pragma unroll
            for (int g = 0; g < 4; ++g) { u32x2 w; w.x = pk2(o[db][4 * g], o[db][4 * g + 1]); w.y = pk2(o[db][4 * g + 2], o[db][4 * g + 3]); *(u32x2*)(op + 32 * db + 8 * g) = w; }
    }
}

DI void gla_cum(const bf16* Z, size_t tok0, int h, const float* wlr, const float* blr, LAS float* part, int tid, float (&bc)[16], float& bend) {
    const int k = tid & 127, tg = tid >> 7;
    float wl[16];
#pragma unroll
    for (int r = 0; r < 16; ++r) wl[r] = wlr[r * 512 + h * 128 + k];
    const float bias = blr[h * 128 + k];
    float run = 0.f;
#pragma unroll
    for (int i = 0; i < 16; ++i) {
        const bf16* gp = Z + (tok0 + tg * 16 + i) * ZC + ZLR; const u32x4 a = *(const u32x4*)gp, c = *(const u32x4*)(gp + 8);
        float pre = bias;
        pre += bflo(a.x) * wl[0] + bfhi(a.x) * wl[1] + bflo(a.y) * wl[2] + bfhi(a.y) * wl[3] + bflo(a.z) * wl[4] + bfhi(a.z) * wl[5] + bflo(a.w) * wl[6] + bfhi(a.w) * wl[7];
        pre += bflo(c.x) * wl[8] + bfhi(c.x) * wl[9] + bflo(c.y) * wl[10] + bfhi(c.y) * wl[11] + bflo(c.z) * wl[12] + bfhi(c.z) * wl[13] + bflo(c.w) * wl[14] + bfhi(c.w) * wl[15];
        run += flogsigmoid(pre) * (1.0f / 16.0f); bc[i] = run;
    }
    part[tg * 128 + k] = run;
    __syncthreads();
    float off = 0.f, tot = 0.f;
#pragma unroll
    for (int g = 0; g < 4; ++g) { const float pv = part[g * 128 + k]; tot += pv; off += (g < tg) ? pv : 0.f; }
#pragma unroll
    for (int i = 0; i < 16; ++i) bc[i] += off;
    bend = tot;
    __syncthreads();
}
#define MFMA16(a, b, c) __builtin_amdgcn_mfma_f32_16x16x32_bf16((a), (b), (c), 0, 0, 0)
DI void phase_gla1(const Frame& F0, const bf16* Z, const bf16* GVT, const float* wlr, const float* blr, bf16* SBUF, float* DBUF) {
    const Frame F = fresh(F0);
    LAS float* part = (LAS float*)F.lds;
    LAS unsigned char* KT = F.lds + 2048;
    const int k = F.tid & 127, tg = F.tid >> 7, l15 = F.lane & 15, l4 = F.lane >> 4;
    for (int un = blockIdx.x; un < 2048; un += F.G) {
        const int n = un & 127, bh = un >> 7, b = bh >> 2, h = bh & 3;
        const size_t tok0 = (size_t)b * SEQ + n * 64;
        float bc[16], bend; gla_cum(Z, tok0, h, wlr, blr, part, F.tid, bc, bend);
        unsigned w[8];
#pragma unroll
        for (int i = 0; i < 8; ++i) {
            const float k0 = bf2f(Z[(tok0 + tg * 16 + 2 * i) * ZC + ZGK + h * 128 + k]) * fexp2((bend - bc[2 * i]) * LOG2E);
            const float k1 = bf2f(Z[(tok0 + tg * 16 + 2 * i + 1) * ZC + ZGK + h * 128 + k]) * fexp2((bend - bc[2 * i + 1]) * LOG2E);
            w[i] = pk2(k0, k1); }
        *(LAS u32x4*)(KT + k * 144 + tg * 32) = (u32x4){w[0], w[1], w[2], w[3]};
        *(LAS u32x4*)(KT + k * 144 + tg * 32 + 16) = (u32x4){w[4], w[5], w[6], w[7]};
        if (tg == 0) DBUF[(size_t)un * 128 + k] = fexp2(bend * LOG2E);
        __syncthreads();
        f32x4 acc[8][2];
#pragma unroll
        for (int mb = 0; mb < 8; ++mb)
#pragma unroll
            for (int nb = 0; nb < 2; ++nb) acc[mb][nb] = (f32x4){0.f, 0.f, 0.f, 0.f};
#pragma unroll
        for (int ks = 0; ks < 2; ++ks) {
            bf16x8 bfr[2];
#pragma unroll
            for (int nb = 0; nb < 2; ++nb) bfr[nb] = *(const bf16x8*)(GVT + (size_t)(b * 1024 + h * 256 + 32 * F.wave + 16 * nb + l15) * SEQ + n * 64 + 32 * ks + 8 * l4);
#pragma unroll
            for (int mb = 0; mb < 8; ++mb) { const bf16x8 a = *(const LAS bf16x8*)(KT + (16 * mb + l15) * 144 + (32 * ks + 8 * l4) * 2);
#pragma unroll
                for (int nb = 0; nb < 2; ++nb) acc[mb][nb] = MFMA16(a, bfr[nb], acc[mb][nb]); }
        }
#pragma unroll
        for (int mb = 0; mb < 8; ++mb)
#pragma unroll
            for (int nb = 0; nb < 2; ++nb) { const int dv = 32 * F.wave + 16 * nb + l15; u32x2 o; o.x = pk2(acc[mb][nb].x, acc[mb][nb].y); o.y = pk2(acc[mb][nb].z, acc[mb][nb].w);
                *(u32x2*)(SBUF + ((size_t)un * 256 + dv) * 128 + 16 * mb + 4 * l4) = o; }
        __syncthreads();
    }
}
DI void phase_gla2(const Frame& F0, bf16* SBUF, const float* DBUF) {
    const Frame F = fresh(F0);
    for (int e = blockIdx.x * NTHR + F.tid; e < 16 * 256 * 32; e += F.G * NTHR) {
        const int bh = e >> 13, rem = e & 8191, dv = rem >> 5, k4 = (rem & 31) * 4;
        f32x4 s = (f32x4){0.f, 0.f, 0.f, 0.f};
#pragma unroll 4
        for (int n = 0; n < 128; ++n) {
            const size_t un = (size_t)bh * 128 + n;
            const f32x4 d = *(const f32x4*)(DBUF + un * 128 + k4); u32x2* p = (u32x2*)(SBUF + (un * 256 + dv) * 128 + k4); const u32x2 u = *p;
            s.x = d.x * s.x + bflo(u.x); s.y = d.y * s.y + bfhi(u.x); s.z = d.z * s.z + bflo(u.y); s.w = d.w * s.w + bfhi(u.y);
            u32x2 o; o.x = pk2(s.x, s.y); o.y = pk2(s.z, s.w); *p = o;
        }
    }
}
DI void phase_gla3(const Frame& F0, bf16* Z, const bf16* GVT, const float* wlr, const float* blr, const float* gout, const bf16* SBUF) {
    const Frame F = fresh(F0);
    LAS float* part = (LAS float*)F.lds;
    LAS float* RS = (LAS float*)(F.lds + 2048);
    LAS unsigned char* QS = F.lds + 4096;
    LAS unsigned char* KS = QS + 17408;
    LAS unsigned char* SC = KS + 17408;
    const int k = F.tid & 127, tg = F.tid >> 7, l15 = F.lane & 15, l4 = F.lane >> 4, w = F.wave;
    for (int un = blockIdx.x; un < 2048; un += F.G) {
        const int n = un & 127, bh = un >> 7, b = bh >> 2, h = bh & 3;
        const size_t tok0 = (size_t)b * SEQ + n * 64;
        float bc[16], bend; gla_cum(Z, tok0, h, wlr, blr, part, F.tid, bc, bend);
#pragma unroll
        for (int i = 0; i < 16; ++i) {
            const size_t tok = tok0 + tg * 16 + i;
            const float qv = bf2f(Z[tok * ZC + ZGQ + h * 128 + k]) * 0.08838834764831845f * fexp2(bc[i] * LOG2E);
            const float kv = bf2f(Z[tok * ZC + ZGK + h * 128 + k]) * fexp2(-bc[i] * LOG2E);
            *(LAS bf16*)(QS + (tg * 16 + i) * 272 + k * 2) = (bf16)(pk2(qv, 0.f) & 0xffffu);
            *(LAS bf16*)(KS + (tg * 16 + i) * 272 + k * 2) = (bf16)(pk2(kv, 0.f) & 0xffffu);
        }
        __syncthreads();
        {
            const int mb = w >> 1;
#pragma unroll
            for (int q = 0; q < 2; ++q) {
                const int nb = 2 * (w & 1) + q;
                f32x4 sc = (f32x4){0.f, 0.f, 0.f, 0.f};
                if (mb <= nb) {
#pragma unroll
                    for (int ks = 0; ks < 4; ++ks) { const bf16x8 a = *(const LAS bf16x8*)(KS + (16 * mb + l15) * 272 + (32 * ks + 8 * l4) * 2), bq = *(const LAS bf16x8*)(QS + (16 * nb + l15) * 272 + (32 * ks + 8 * l4) * 2);
                        sc = MFMA16(a, bq, sc); } }
                const int t = 16 * nb + l15, s_ = 16 * mb + 4 * l4;
                const float v0 = (s_ + 0 <= t) ? sc.x : 0.f, v1 = (s_ + 1 <= t) ? sc.y : 0.f, v2 = (s_ + 2 <= t) ? sc.z : 0.f, v3 = (s_ + 3 <= t) ? sc.w : 0.f;
                u32x2 o; o.x = pk2(v0, v1); o.y = pk2(v2, v3); *(LAS u32x2*)(SC + t * 144 + s_ * 2) = o;
            }
        }
        __syncthreads();
        f32x4 acc[2][4];
#pragma unroll
        for (int mb = 0; mb < 2; ++mb)
#pragma unroll
            for (int nb = 0; nb < 4; ++nb) acc[mb][nb] = (f32x4){0.f, 0.f, 0.f, 0.f};
        if (n > 0) {
#pragma unroll
            for (int ks = 0; ks < 4; ++ks) {
                bf16x8 a[2], bq[4];
#pragma unroll
                for (int mb = 0; mb < 2; ++mb) a[mb] = *(const bf16x8*)(SBUF + ((size_t)(un - 1) * 256 + 32 * w + 16 * mb + l15) * 128 + 32 * ks + 8 * l4);
#pragma unroll
                for (int nb = 0; nb < 4; ++nb) bq[nb] = *(const LAS bf16x8*)(QS + (16 * nb + l15) * 272 + (32 * ks + 8 * l4) * 2);
#pragma unroll
                for (int mb = 0; mb < 2; ++mb)
#pragma unroll
                    for (int nb = 0; nb < 4; ++nb) acc[mb][nb] = MFMA16(a[mb], bq[nb], acc[mb][nb]);
            }
        }
#pragma unroll
        for (int ks = 0; ks < 2; ++ks) {
            bf16x8 a[2], bq[4];
#pragma unroll
            for (int mb = 0; mb < 2; ++mb) a[mb] = *(const bf16x8*)(GVT + (size_t)(b * 1024 + h * 256 + 32 * w + 16 * mb + l15) * SEQ + n * 64 + 32 * ks + 8 * l4);
#pragma unroll
            for (int nb = 0; nb < 4; ++nb) bq[nb] = *(const LAS bf16x8*)(SC + (16 * nb + l15) * 144 + (32 * ks + 8 * l4) * 2);
#pragma unroll
            for (int mb = 0; mb < 2; ++mb)
#pragma unroll
                for (int nb = 0; nb < 4; ++nb) acc[mb][nb] = MFMA16(a[mb], bq[nb], acc[mb][nb]);
        }
#pragma unroll
        for (int nb = 0; nb < 4; ++nb) {
            float ss = 0.f;
#pragma unroll
            for (int mb = 0; mb < 2; ++mb) ss += (acc[mb][nb].x * acc[mb][nb].x + acc[mb][nb].y * acc[mb][nb].y) + (acc[mb][nb].z * acc[mb][nb].z + acc[mb][nb].w * acc[mb][nb].w);
            ss += __shfl_xor(ss, 16); ss += __shfl_xor(ss, 32);
            if (l4 == 0) RS[w * 64 + 16 * nb + l15] = ss;
        }
        __syncthreads();
#pragma unroll
        for (int nb = 0; nb < 4; ++nb) {
            const int t = 16 * nb + l15; float tot = 0.f;
#pragma unroll
            for (int ww = 0; ww < 8; ++ww) tot += RS[ww * 64 + t];
            const float rstd = frsq(tot * (1.0f / 256.0f) + EPS);
#pragma unroll
            for (int mb = 0; mb < 2; ++mb) {
                const int dv = 32 * w + 16 * mb + 4 * l4; const f32x4 g4 = *(const f32x4*)(gout + dv);
                u32x2* gp = (u32x2*)(Z + (tok0 + t) * ZC + ZGR + h * 256 + dv); const u32x2 gr = *gp;
                const f32x4 a = acc[mb][nb];
                u32x2 o; o.x = pk2(a.x * rstd * g4.x * fsilu(bflo(gr.x)), a.y * rstd * g4.y * fsilu(bfhi(gr.x))); o.y = pk2(a.z * rstd * g4.z * fsilu(bflo(gr.y)), a.w * rstd * g4.w * fsilu(bfhi(gr.y)));
                *gp = o;
            }
        }
        __syncthreads();
    }
}

DI void phase_moe_pos(const Frame& F0, int hf, const int* sel, const float* selw, const int* cnt, int* slot, float* roww, int* tile_e, const bf16* HB, bf16* ASORT) {
    const Frame F = fresh(F0);
    const int c = blockIdx.x; if ((c >> 7) != hf) return;
    const int lc = c & 127, tid = F.tid;
    LAS int* s_sel = (LAS int*)F.lds; LAS int* s_tot = s_sel + 128; LAS int* s_bef = s_tot + 8; LAS int* s_off = s_bef + 8; LAS int* s_pos = s_off + 8;
    if (tid < 128) s_sel[tid] = sel[c * 128 + tid];
    if (tid < NE) { int tot = 0, bef = 0; for (int w = 0; w < 128; ++w) { const int v = cnt[(hf * 128 + w) * NE + tid]; tot += v; bef += (w < lc) ? v : 0; } s_tot[tid] = tot; s_bef[tid] = bef; }
    __syncthreads();
    if (tid == 0) {
        int base = 0;
        for (int e = 0; e < NE; ++e) { s_off[e] = base + s_bef[e]; const int nt = (s_tot[e] + 255) >> 8; if (lc == 0) for (int t = 0; t < nt; ++t) tile_e[hf * 256 + 1 + (base >> 8) + t] = e; base += nt * 256; }
        if (lc == 0) tile_e[hf * 256] = base >> 8;
        for (int i = 0; i < 128; ++i) { const int s = s_sel[i], tok = c * 128 + i;
            for (int j = 0; j < 2; ++j) { const int e = j ? (s >> 8) : (s & 255); const int pos = s_off[e]; s_off[e] = pos + 1; s_pos[2 * i + j] = pos; slot[2 * tok + j] = pos; roww[hf * SORT_ROWS + pos] = selw[2 * tok + j]; } }
    }
    __syncthreads();
    for (int it = 0; it < 128; ++it) { const int p = it * 2 + (tid >> 8), tok = c * 128 + (p >> 1), pos = s_pos[p];
        *(u32x4*)(ASORT + (size_t)pos * D + (tid & 255) * 8) = *(const u32x4*)(HB + (size_t)tok * D + (tid & 255) * 8); }
    __syncthreads();
}
DI void phase_moe_combine(const Frame& F0, int hf, const int* slot, const bf16* YSORT, float* X, bf16* HB) {
    const Frame F = fresh(F0);
    for (int m = hf * HALF_T + F.gw; m < (hf + 1) * HALF_T; m += F.ngw) {
        const int p0 = slot[2 * m], p1 = slot[2 * m + 1];
#pragma unroll
        for (int j = 0; j < 8; ++j) { const int idx = F.lane + 64 * j; f32x4 x = ((const f32x4*)(X + (size_t)m * D))[idx];
            const u32x2 y0 = ((const u32x2*)(YSORT + (size_t)p0 * D))[idx], y1 = ((const u32x2*)(YSORT + (size_t)p1 * D))[idx];
            x.x += bflo(y0.x) + bflo(y1.x); x.y += bfhi(y0.x) + bfhi(y1.x); x.z += bflo(y0.y) + bflo(y1.y); x.w += bfhi(y0.y) + bfhi(y1.y);
            ((f32x4*)(X + (size_t)m * D))[idx] = x; u32x2 o; o.x = pk2(x.x, x.y); o.y = pk2(x.z, x.w); ((u32x2*)(HB + (size_t)m * D))[idx] = o; }
    }
}

using pg8::Unit;
typedef f32x4 AccT[2][2][4][2];
constexpr float GATE_TINY = 8.673617379884035e-19f;
struct PBase { pg8::StaticOrder so; int K, lda, ldb; };
DI u32x4 pack8(const f32x4& a, const f32x4& b) { u32x4 w; w.x = pk2(a.x, a.y); w.y = pk2(a.z, a.w); w.z = pk2(b.x, b.y); w.w = pk2(b.z, b.w); return w; }
DI void unpack8(const u32x4& w, f32x4& a, f32x4& b) { a = (f32x4){bflo(w.x), bfhi(w.x), bflo(w.y), bfhi(w.y)}; b = (f32x4){bflo(w.z), bfhi(w.z), bflo(w.w), bfhi(w.w)}; }
DI f32x4 sig4(const f32x4& v) { return (f32x4){fsigmoid(v.x), fsigmoid(v.y), fsigmoid(v.z), fsigmoid(v.w)}; }
DI f32x4 max4(const f32x4& v, float m) { return (f32x4){fmaxf(v.x, m), fmaxf(v.y, m), fmaxf(v.z, m), fmaxf(v.w, m)}; }
DI f32x4 rcp4(const f32x4& v) { return (f32x4){frcp(v.x), frcp(v.y), frcp(v.z), frcp(v.w)}; }
DI f32x4 swi4(const f32x4& a, const f32x4& b) { return (f32x4){fsilu(a.x) * b.x, fsilu(a.y) * b.y, fsilu(a.z) * b.z, fsilu(a.w) * b.w}; }

struct PInGates : PBase {
    static constexpr bool PERM = true;
    const bf16* A; const bf16* Bt; bf16* Zo; bf16* Go; const float* bias;
    DI bool next(int i, Unit& u) const { u.aux = 0; return so.tile(i, u.pm, u.pn); }
    DI const char* a_base(const Unit& u) const { return (const char*)(A + (size_t)u.pm * 256 * lda); }
    DI const char* b_base(const Unit& u) const { return (const char*)(Bt + (size_t)u.pn * 256 * ldb); }
    DI bool epi(AccT& acc, const Unit& u, int wr, int wc, int fr, int fq) const {
        const int row0 = u.pm * 256 + wr * 64 + fr;
        if (u.pn < ZC / 256) {
            const int col0 = u.pn * 256 + wc * 32 + 8 * fq;
#pragma unroll
            for (int ai = 0; ai < 2; ++ai)
#pragma unroll
                for (int m = 0; m < 4; ++m) { bf16* rowp = Zo + (size_t)(row0 + ai * 128 + m * 16) * ZC + col0;
#pragma unroll
                    for (int bj = 0; bj < 2; ++bj) *(u32x4*)(rowp + bj * 128) = pack8(acc[ai][bj][m][0], acc[ai][bj][m][1]); }
        } else {
            const int col0 = (u.pn - ZC / 256) * 256 + wc * 32 + 8 * fq;
            f32x4 bv[2][2];
#pragma unroll
            for (int bj = 0; bj < 2; ++bj)
#pragma unroll
                for (int n = 0; n < 2; ++n) bv[bj][n] = *(const f32x4*)(bias + col0 + bj * 128 + 4 * n);
#pragma unroll
            for (int ai = 0; ai < 2; ++ai)
#pragma unroll
                for (int m = 0; m < 4; ++m) { bf16* rowp = Go + (size_t)(row0 + ai * 128 + m * 16) * GC + col0;
#pragma unroll
                    for (int bj = 0; bj < 2; ++bj) *(u32x4*)(rowp + bj * 128) = pack8(sig4(acc[ai][bj][m][0] + bv[bj][0]), sig4(acc[ai][bj][m][1] + bv[bj][1])); }
        }
        return true;
    }
};
struct PPool : PBase {
    static constexpr bool PERM = true;
    const bf16* A; const bf16* Bt; bf16* Zo; const float* scale;
    DI bool next(int i, Unit& u) const { u.aux = 0; return so.tile(i, u.pm, u.pn); }
    DI const char* a_base(const Unit& u) const { return (const char*)(A + (size_t)u.pm * 256 * 1024 + u.pn * 256); }
    DI const char* b_base(const Unit& u) const { return (const char*)(Bt + (size_t)u.pn * 256 * 256); }
    DI bool epi(AccT& acc, const Unit& u, int wr, int wc, int fr, int fq) const {
        const int row0 = u.pm * 256 + wr * 64 + fr, col0 = u.pn * 256 + wc * 32 + 8 * fq;
        f32x4 sv[2][2];
#pragma unroll
        for (int bj = 0; bj < 2; ++bj)
#pragma unroll
            for (int n = 0; n < 2; ++n) sv[bj][n] = *(const f32x4*)(scale + col0 + bj * 128 + 4 * n);
#pragma unroll
        for (int ai = 0; ai < 2; ++ai)
#pragma unroll
            for (int m = 0; m < 4; ++m) { bf16* rowp = Zo + (size_t)(row0 + ai * 128 + m * 16) * ZC + ZU + col0;
#pragma unroll
                for (int bj = 0; bj < 2; ++bj) *(u32x4*)(rowp + bj * 128) = pack8(acc[ai][bj][m][0] * sv[bj][0], acc[ai][bj][m][1] * sv[bj][1]); }
        return true;
    }
};
struct PUp : PBase {
    static constexpr bool PERM = true;
    const bf16* Zi; const bf16* Wup; const bf16* Gi; bf16* Mo;
    DI bool next(int i, Unit& u) const { u.aux = i % 3; return so.tile(i / 3, u.pm, u.pn); }
    DI const char* a_base(const Unit& u) const { return (const char*)(Zi + (size_t)u.pm * 256 * ZC + (u.aux == 0 ? ZU : (u.aux == 1 ? ZSQ : ZGR))); }
    DI const char* b_base(const Unit& u) const { return (const char*)(Wup + (size_t)u.aux * 2048 * 1024 + (size_t)u.pn * 256 * 1024); }
    DI bool epi(AccT& acc, const Unit& u, int wr, int wc, int fr, int fq) const {
        const int row0 = u.pm * 256 + wr * 64 + fr, col0 = u.pn * 256 + wc * 32 + 8 * fq;
        const bool lastb = (u.aux == 2);
#pragma unroll
        for (int ai = 0; ai < 2; ++ai)
#pragma unroll
            for (int m = 0; m < 4; ++m) { const size_t r = (size_t)(row0 + ai * 128 + m * 16); const bf16* gp = Gi + r * GC + u.aux * 2048 + col0; const bf16* gn = lastb ? gp : gp + 2048; bf16* op = Mo + r * D + col0;
#pragma unroll
                for (int bj = 0; bj < 2; ++bj) { f32x4 c0, c1, n0, n1; unpack8(*(const u32x4*)(gp + bj * 128), c0, c1); unpack8(*(const u32x4*)(gn + bj * 128), n0, n1);
                    f32x4 r0 = rcp4(max4(n0, GATE_TINY)), r1 = rcp4(max4(n1, GATE_TINY));
                    if (lastb) { r0 = (f32x4){1.f, 1.f, 1.f, 1.f}; r1 = r0; }
                    acc[ai][bj][m][0] = acc[ai][bj][m][0] * (max4(c0, GATE_TINY) * r0); acc[ai][bj][m][1] = acc[ai][bj][m][1] * (max4(c1, GATE_TINY) * r1);
                    if (lastb) *(u32x4*)(op + bj * 128) = pack8(acc[ai][bj][m][0], acc[ai][bj][m][1]); }
                asm volatile("" ::: "memory"); }
        return lastb;
    }
};
template <int MODE> struct PResid : PBase {
    static constexpr bool PERM = false;
    const bf16* A; const bf16* Bt; float* X; bf16* XB; const bf16* PPi;
    DI bool next(int i, Unit& u) const { u.aux = 0; return so.tile(i, u.pm, u.pn); }
    DI const char* a_base(const Unit& u) const { return (const char*)(A + (size_t)u.pm * 256 * lda); }
    DI const char* b_base(const Unit& u) const { return (const char*)(Bt + (size_t)u.pn * 256 * ldb); }
    DI bool epi(AccT& acc, const Unit& u, int wr, int wc, int fr, int fq) const {
        const int row0 = u.pm * 256 + wr * 64 + fr, col0 = u.pn * 256 + wc * 32 + 4 * fq;
#pragma unroll
        for (int ai = 0; ai < 2; ++ai)
#pragma unroll
            for (int m = 0; m < 4; ++m) { const size_t off = (size_t)(row0 + ai * 128 + m * 16) * D + col0;
#pragma unroll
                for (int bj = 0; bj < 2; ++bj)
#pragma unroll
                    for (int n = 0; n < 2; ++n) { f32x4* p = (f32x4*)(X + off + bj * 128 + n * 16); f32x4 a = acc[ai][bj][m][n];
                        if (MODE == 2) { const u32x2 pw = *(const u32x2*)(PPi + off + bj * 128 + n * 16); a = sig4(a) * (f32x4){bflo(pw.x), bfhi(pw.x), bflo(pw.y), bfhi(pw.y)}; }
                        const f32x4 x = *p + a; *p = x;
                        if (MODE == 1) { u32x2 o; o.x = pk2(x.x, x.y); o.y = pk2(x.z, x.w); *(u32x2*)(XB + off + bj * 128 + n * 16) = o; } } }
        return true;
    }
};
template <bool GROUPED> struct PSwiglu : PBase {
    static constexpr bool PERM = true;
    const bf16* A; const unsigned char* Bt; bf16* O; const int* tile_e;
    DI bool next(int i, Unit& u) const { const bool ok = so.tile(i, u.pm, u.pn); u.aux = (GROUPED && ok) ? tile_e[1 + u.pm] : 0; return ok; }
    DI const char* a_base(const Unit& u) const { return (const char*)(A + (size_t)u.pm * 256 * lda); }
    DI const char* b_base(const Unit& u) const { return (const char*)(Bt + (size_t)u.aux * WMOE_E + (size_t)u.pn * 256 * ldb * 2); }
    DI bool epi(AccT& acc, const Unit& u, int wr, int wc, int fr, int fq) const {
        const int row0 = u.pm * 256 + wr * 64 + fr, col0 = u.pn * 128 + wc * 32 + 8 * fq;
#pragma unroll
        for (int ai = 0; ai < 2; ++ai)
#pragma unroll
            for (int m = 0; m < 4; ++m) *(u32x4*)(O + (size_t)(row0 + ai * 128 + m * 16) * DFF + col0) = pack8(swi4(acc[ai][0][m][0], acc[ai][1][m][0]), swi4(acc[ai][0][m][1], acc[ai][1][m][1]));
        return true;
    }
};
template <bool GROUPED> struct PBf16 : PBase {
    static constexpr bool PERM = true;
    const bf16* A; const unsigned char* Bt; bf16* O; int ldo; const int* tile_e; const float* rw;
    DI bool next(int i, Unit& u) const { const bool ok = so.tile(i, u.pm, u.pn); u.aux = (GROUPED && ok) ? tile_e[1 + u.pm] : 0; return ok; }
    DI const char* a_base(const Unit& u) const { return (const char*)(A + (size_t)u.pm * 256 * lda); }
    DI const char* b_base(const Unit& u) const { return (const char*)(Bt + (size_t)u.aux * WMOE_E + (size_t)u.pn * 256 * ldb * 2); }
    DI bool epi(AccT& acc, const Unit& u, int wr, int wc, int fr, int fq) const {
        const int row0 = u.pm * 256 + wr * 64 + fr, col0 = u.pn * 256 + wc * 32 + 8 * fq;
#pragma unroll
        for (int ai = 0; ai < 2; ++ai)
#pragma unroll
            for (int m = 0; m < 4; ++m) { const int r = row0 + ai * 128 + m * 16; const float s = GROUPED ? rw[r] : 1.0f; bf16* rowp = O + (size_t)r * ldo + col0;
#pragma unroll
                for (int bj = 0; bj < 2; ++bj) *(u32x4*)(rowp + bj * 128) = pack8(acc[ai][bj][m][0] * s, acc[ai][bj][m][1] * s); }
        return true;
    }
};

constexpr int PH_PER_LAYER = 18, NPH = 1 + 2 * PH_PER_LAYER;
typedef const Args __attribute__((address_space(4)))* ArgP;
DI ArgP argp() { unsigned long long p = (unsigned long long)__builtin_amdgcn_kernarg_segment_ptr(); asm volatile("" : "+s"(p)); return (ArgP)p; }
#define AIN(k) (argp()->in[k])
__global__ void __launch_bounds__(NTHR, 2) fwd(Args args_unused) {
    extern __shared__ __attribute__((aligned(16))) unsigned char lds_raw[];
    Frame F;
    F.lds = (LAS unsigned char*)lds_raw;
    F.tid = threadIdx.x; F.lane = F.tid & 63; F.wave = __builtin_amdgcn_readfirstlane(F.tid >> 6);
    F.G = gridDim.x; { const int bx = blockIdx.x; F.vcu = (F.G % 8 == 0) ? (bx % 8) * (F.G / 8) + bx / 8 : bx; }
    F.gw = F.vcu * NWAVES + F.wave; F.ngw = F.G * NWAVES;
    volatile LAS unsigned* MISC = (volatile LAS unsigned*)(F.lds + MISC_OFF);
    if (F.tid < 16) MISC[F.tid] = 0u;
    __syncthreads();
    unsigned char* ws = argp()->ws;
    unsigned* ctl = (unsigned*)(ws + WS_CTL);
    const int lo = argp()->ph_lo, hi = argp()->ph_hi;
    XcdBarrier bar; bar.bar = ctl + CW_BAR; bar.x = 0; bar.st = MISC + 8;
    if (hi - lo > 1) bar = xcd_barrier_post(ctl + CW_BAR, MISC + 8);
#ifndef ONLY_SITE
#define ONLY_SITE -1
#endif
#ifndef ONLY_SUB
#define ONLY_SUB -1
#endif
#define SITE_ON(k) (ONLY_SITE < 0 || ONLY_SITE == (k))
#define SUB_ON(k) (ONLY_SUB < 0 || ONLY_SUB == (k))
#define IN(k) (lo <= (k) && (k) < hi)
#define SEAM(k) do { if ((k) + 1 < hi) xcd_barrier(bar); } while (0)
    float* X = argp()->out;
    bf16* HB = (bf16*)(ws + WS_HB); bf16* PP = (bf16*)(ws + WS_PP); bf16* Z = (bf16*)(ws + WS_Z); bf16* GATES = (bf16*)(ws + WS_GATES);
    bf16* POOLED = (bf16*)(ws + WS_POOLED); bf16* SVT = (bf16*)(ws + WS_SVT); bf16* GVT = (bf16*)(ws + WS_GVT); bf16* SBUF = (bf16*)(ws + WS_SBUF);
    float* DBUF = (float*)(ws + WS_DBUF);
    int* SEL = (int*)(ws + WS_MISC + MISC_SEL); float* SELW = (float*)(ws + WS_MISC + MISC_SELW); int* SLOT = (int*)(ws + WS_MISC + MISC_SLOT); int* CNT = (int*)(ws + WS_MISC + MISC_CNT);
    float* ROWW = (float*)(ws + WS_MISC + MISC_ROWW); int* TILE_E = (int*)(ws + WS_MISC + MISC_TILE);
    const int c = (int)blockIdx.x;

    if (SITE_ON(100) && IN(0)) {
        int rot = 0;
        for (int L = 0; L < 2; ++L) {
            unsigned char* wl = ws + WS_W + (size_t)L * WL_SIZE;
            convert_matrix(F, AIN(I_WIN) + (size_t)L * D * IN_COLS, D, IN_COLS, (bf16*)(wl + WL_WIN), 1, 0, rot); rot += 32 * 225;
            convert_matrix(F, AIN(I_WBG) + (size_t)L * D * GC, D, GC, (bf16*)(wl + WL_WIN), 0, ZC, rot); rot += 32 * 192;
            for (int g = 0; g < 4; ++g) { convert_matrix(F, AIN(I_POOLW) + (size_t)(L * 4 + g) * 65536, 256, 256, (bf16*)(wl + WL_POOL) + g * 65536, 0, 0, rot); rot += 32; }
            convert_matrix(F, AIN(I_WUPP) + (size_t)L * 1024 * D, 1024, D, (bf16*)(wl + WL_WUP), 0, 0, rot); rot += 16 * 64;
            convert_matrix(F, AIN(I_WUPS) + (size_t)L * 1024 * D, 1024, D, (bf16*)(wl + WL_WUP) + (size_t)1 * D * 1024, 0, 0, rot); rot += 16 * 64;
            convert_matrix(F, AIN(I_WUPG) + (size_t)L * 1024 * D, 1024, D, (bf16*)(wl + WL_WUP) + (size_t)2 * D * 1024, 0, 0, rot); rot += 16 * 64;
            convert_matrix(F, AIN(I_WO) + (size_t)L * D * D, D, D, (bf16*)(wl + WL_WO), 0, 0, rot); rot += 32 * 64;
            convert_matrix(F, AIN(I_PLEP) + (size_t)L * PLE * D, PLE, D, (bf16*)(wl + WL_PLEP), 0, 0, rot); rot += 4 * 64;
            convert_matrix(F, AIN(I_PLEG) + (size_t)L * D * D, D, D, (bf16*)(wl + WL_PLEG), 0, 0, rot); rot += 32 * 64;
        }
        convert_matrix(F, AIN(I_FW1), D, DFF, (bf16*)(ws + WS_FFN13), 2, 0, rot); rot += 32 * 176;
        convert_matrix(F, AIN(I_FW3), D, DFF, (bf16*)(ws + WS_FFN13), 3, 0, rot); rot += 32 * 176;
        convert_matrix(F, AIN(I_FW2), DFF, D, (bf16*)(ws + WS_FFN2), 0, 0, rot);
        {
            const f32x4* src = (const f32x4*)AIN(I_P); u32x4* dst = (u32x4*)(ws + WS_PB);
            for (size_t i = (size_t)blockIdx.x * NTHR + F.tid; i < (size_t)2 * T * PLE / 8; i += (size_t)F.G * NTHR) dst[i] = pack8(src[2 * i], src[2 * i + 1]);
        }
        SEAM(0);
    }

    for (int L = 0; L < 2; ++L) {
        const int pb = 1 + L * PH_PER_LAYER;
        unsigned char* wl = ws + WS_W + (size_t)L * WL_SIZE;
        if (SITE_ON(0) && IN(pb + 0)) { phase_rmsnorm(F, L == 0 ? AIN(I_X) : X, AIN(I_GMIX) + L * D, HB, L == 0 ? X : nullptr); SEAM(pb + 0); }
        if (SITE_ON(1) && IN(pb + 1)) {
            PInGates P; P.so.init(T / 256, NIN / 256, F.G, c); P.K = D; P.lda = D; P.ldb = D; P.A = HB; P.Bt = (const bf16*)(wl + WL_WIN); P.Zo = Z; P.Go = GATES; P.bias = AIN(I_BBG) + L * GC;
            pg8::gemm_phase(F.lds, P); SEAM(pb + 1);
        }
        if (SITE_ON(2) && IN(pb + 2)) { phase_postproj(F, Z, AIN(I_SBGQ) + L * 128, AIN(I_SBGK) + L * 128, POOLED, SVT, GVT); SEAM(pb + 2); }
        if (SITE_ON(3) && IN(pb + 3)) {
            if (SUB_ON(0)) { PPool P; P.so.init(T / 256, 4, F.G, c); P.K = 256; P.lda = 1024; P.ldb = 256; P.A = POOLED; P.Bt = (const bf16*)(wl + WL_POOL); P.Zo = Z; P.scale = AIN(I_POOLS) + L * 1024;
              pg8::gemm_phase(F.lds, P); }
            if (SUB_ON(1)) { PBf16<false> P; P.so.init(T / 256, D / 256, F.G, c); P.K = PLE; P.lda = PLE; P.ldb = PLE; P.A = (const bf16*)(ws + WS_PB) + (size_t)L * T * PLE; P.Bt = wl + WL_PLEP; P.O = PP; P.ldo = D; P.tile_e = nullptr; P.rw = nullptr;
              pg8::gemm_phase(F.lds, P); }
            __syncthreads();
            if (SUB_ON(2)) phase_sb(F, Z, SVT);
            __syncthreads();
            if (SUB_ON(3)) phase_gla1(F, Z, GVT, AIN(I_GLAWLR) + L * 16 * 512, AIN(I_GLABLR) + L * 512, SBUF, DBUF);
            SEAM(pb + 3);
        }
        if (SITE_ON(4) && IN(pb + 4)) { phase_gla2(F, SBUF, DBUF); SEAM(pb + 4); }
        if (SITE_ON(5) && IN(pb + 5)) { phase_gla3(F, Z, GVT, AIN(I_GLAWLR) + L * 16 * 512, AIN(I_GLABLR) + L * 512, AIN(I_GLAGOUT) + L * 256, SBUF); SEAM(pb + 5); }
        if (SITE_ON(6) && IN(pb + 6)) {
            PUp P; P.so.init(T / 256, D / 256, F.G, c); P.K = 1024; P.lda = ZC; P.ldb = 1024; P.Zi = Z; P.Wup = (const bf16*)(wl + WL_WUP); P.Gi = GATES; P.Mo = HB;
            pg8::gemm_phase(F.lds, P); SEAM(pb + 6);
        }
        if (SITE_ON(7) && IN(pb + 7)) {
            PResid<0> P; P.so.init(T / 256, D / 256, F.G, c); P.K = D; P.lda = D; P.ldb = D; P.A = HB; P.Bt = (const bf16*)(wl + WL_WO); P.X = X; P.XB = nullptr; P.PPi = nullptr;
            pg8::gemm_phase(F.lds, P); SEAM(pb + 7);
        }
        if (SITE_ON(8) && IN(pb + 8)) {
            if (L == 0) phase_rmsnorm(F, X, AIN(I_GFFN) + L * D, HB, nullptr);
            else {
                phase_rmsnorm_route(F, X, AIN(I_GFFN) + L * D, HB, AIN(I_ROUTER), SEL, SELW, CNT);
                int rot = 0;
                for (int e = 0; e < NE; ++e) {
                    unsigned char* we = ws + WS_WMOE + (size_t)e * WMOE_E;
                    convert_matrix(F, AIN(I_MW1) + (size_t)e * D * DFF, D, DFF, (bf16*)we, 2, 0, rot); rot += 32 * 176;
                    convert_matrix(F, AIN(I_MW3) + (size_t)e * D * DFF, D, DFF, (bf16*)we, 3, 0, rot); rot += 32 * 176;
                    convert_matrix(F, AIN(I_MW2) + (size_t)e * DFF * D, DFF, D, (bf16*)(we + WMOE_W2), 0, 0, rot); rot += 88 * 64;
                }
            }
            SEAM(pb + 8);
        }
        if (L == 0) {
            if (SITE_ON(9) && IN(pb + 9)) {
                PSwiglu<false> P; P.so.init(T / 256, DFF / 128, F.G, c); P.K = D; P.lda = D; P.ldb = D; P.A = HB; P.Bt = ws + WS_FFN13; P.O = (bf16*)(ws + WS_ACT); P.tile_e = nullptr;
                pg8::gemm_phase(F.lds, P); SEAM(pb + 9);
            }
            if (SITE_ON(10) && IN(pb + 10)) {
                PResid<1> P; P.so.init(T / 256, D / 256, F.G, c); P.K = DFF; P.lda = DFF; P.ldb = DFF; P.A = (const bf16*)(ws + WS_ACT); P.Bt = (const bf16*)(ws + WS_FFN2); P.X = X; P.XB = HB; P.PPi = nullptr;
                pg8::gemm_phase(F.lds, P); SEAM(pb + 10);
            }
        } else {
            for (int hf = 0; hf < 2; ++hf) {
                const int kb = pb + 9 + 4 * hf;
                if (SITE_ON(11) && IN(kb + 0)) { phase_moe_pos(F, hf, SEL, SELW, CNT, SLOT, ROWW, TILE_E, HB, (bf16*)(ws + WS_ASORT)); SEAM(kb + 0); }
                if (SITE_ON(12) && IN(kb + 1)) {
                    const int ntiles = TILE_E[hf * 256];
                    PSwiglu<true> P; P.so.init(ntiles, DFF / 128, F.G, c); P.K = D; P.lda = D; P.ldb = D; P.A = (const bf16*)(ws + WS_ASORT); P.Bt = ws + WS_WMOE; P.O = (bf16*)(ws + WS_ACTS); P.tile_e = TILE_E + hf * 256;
                    pg8::gemm_phase(F.lds, P); SEAM(kb + 1);
                }
                if (SITE_ON(13) && IN(kb + 2)) {
                    const int ntiles = TILE_E[hf * 256];
                    PBf16<true> P; P.so.init(ntiles, D / 256, F.G, c); P.K = DFF; P.lda = DFF; P.ldb = DFF; P.A = (const bf16*)(ws + WS_ACTS); P.Bt = ws + WS_WMOE + WMOE_W2; P.O = (bf16*)(ws + WS_YSORT); P.ldo = D;
                    P.tile_e = TILE_E + hf * 256; P.rw = ROWW + hf * SORT_ROWS;
                    pg8::gemm_phase(F.lds, P); SEAM(kb + 2);
                }
                if (SITE_ON(14) && IN(kb + 3)) { phase_moe_combine(F, hf, SLOT, (const bf16*)(ws + WS_YSORT), X, HB); SEAM(kb + 3); }
            }
        }
        if (SITE_ON(17) && IN(pb + 17)) {
            PResid<2> P; P.so.init(T / 256, D / 256, F.G, c); P.K = D; P.lda = D; P.ldb = D; P.A = HB; P.Bt = (const bf16*)(wl + WL_PLEG); P.X = X; P.XB = nullptr; P.PPi = PP;
            pg8::gemm_phase(F.lds, P); SEAM(pb + 17);
        }
    }
#undef IN
#undef SEAM
}

extern "C" void kernel_launch(void* const* d_in, const int* in_sizes, int n_in, void* d_out, int out_size, void* d_ws, size_t ws_size, hipStream_t stream) {
    static int grid = 0;
    if (grid == 0) {
        if (n_in != 27 || in_sizes[0] != T * D || out_size != T * D || ws_size < WS_END) { fprintf(stderr, "kernel_launch: shape/workspace mismatch (n_in %d, in0 %d, out %d, ws %zu < %zu)\n", n_in, n_in > 0 ? in_sizes[0] : -1, out_size, ws_size, (size_t)WS_END); grid = -1; return; }
        int dev = 0, cus = 0, per_cu = 0;
        if (hipGetDevice(&dev) != hipSuccess || hipDeviceGetAttribute(&cus, hipDeviceAttributeMultiprocessorCount, dev) != hipSuccess) { grid = -1; return; }
        if (hipFuncSetAttribute((const void*)fwd, hipFuncAttributeMaxDynamicSharedMemorySize, LDS_BYTES) != hipSuccess) { fprintf(stderr, "kernel_launch: hipFuncSetAttribute failed\n"); grid = -1; return; }
        if (hipOccupancyMaxActiveBlocksPerMultiprocessor(&per_cu, (const void*)fwd, NTHR, LDS_BYTES) != hipSuccess || per_cu < 1) { fprintf(stderr, "kernel_launch: occupancy query says %d blocks per CU\n", per_cu); }
        (void)hipGetLastError();
        if (cus < 256) { fprintf(stderr, "kernel_launch: needs >= 256 CUs (got %d)\n", cus); grid = -1; return; }
        grid = 256;
    }
    if (grid < 0) return;
    (void)hipMemsetAsync((char*)d_ws + WS_CTL, 0, CTL_ZERO_BYTES, stream);
    Args a{};
    for (int i = 0; i < 27; ++i) a.in[i] = (const float*)d_in[i];
    a.out = (float*)d_out; a.ws = (unsigned char*)d_ws;
#if MK_PER_PHASE
    for (int ph = 0; ph < NPH; ++ph) {
        if (ph >= 1 + 11 && ph <= 1 + 16) continue;
        a.ph_lo = ph; a.ph_hi = ph + 1;
        hipLaunchKernelGGL(fwd, dim3(grid), dim3(NTHR), LDS_BYTES, stream, a);
    }
#else
    a.ph_lo = 0; a.ph_hi = NPH;
    hipLaunchKernelGGL(fwd, dim3(grid), dim3(NTHR), LDS_BYTES, stream, a);
#endif
    const hipError_t le = hipPeekAtLastError();
    if (le != hipSuccess) fprintf(stderr, "kernel_launch: launch failed: %s\n", hipGetErrorName(le));
}
```

```cpp
#include <hip/hip_runtime.h>
#include <cstdio>
#include <cstdint>

#ifndef MK_PER_PHASE
#define MK_PER_PHASE 0
#endif

#ifndef DBG_TIME_MASK
#define DBG_TIME_MASK 0ull
#endif
#ifndef DBG_TIME_SCALE
#define DBG_TIME_SCALE 0.01f
#endif
#ifndef DUP_MASK
#define DUP_MASK 0
#endif
#ifndef FP8_SELFTEST
#define FP8_SELFTEST 0
#endif
#ifndef DENSE_FP8
#define DENSE_FP8 0
#endif
#ifndef DENSE2_FP8
#define DENSE2_FP8 1
#endif
#ifndef G3_DUP_MODE
#define G3_DUP_MODE 0
#endif
#define LAS __attribute__((address_space(3)))
#define GAS __attribute__((address_space(1)))
typedef unsigned short bf16;
typedef short bf16x8 __attribute__((ext_vector_type(8)));
typedef float f32x2 __attribute__((ext_vector_type(2)));
typedef float f32x4 __attribute__((ext_vector_type(4)));
typedef float f32x16 __attribute__((ext_vector_type(16)));
typedef unsigned u32x2 __attribute__((ext_vector_type(2)));
typedef unsigned u32x4 __attribute__((ext_vector_type(4)));
typedef __bf16 bf16x2_t __attribute__((ext_vector_type(2)));
typedef int i32x4 __attribute__((ext_vector_type(4)));
typedef int i32x8 __attribute__((ext_vector_type(8)));

#define DI __device__ __forceinline__
DI unsigned pk2(float lo, float hi) { f32x2 v = {lo, hi}; bf16x2_t b = __builtin_convertvector(v, bf16x2_t); return __builtin_bit_cast(unsigned, b); }
DI unsigned pk4_fp8(float a, float b, float c, float d) {
    a = __builtin_amdgcn_fmed3f(a, -448.f, 448.f); b = __builtin_amdgcn_fmed3f(b, -448.f, 448.f); c = __builtin_amdgcn_fmed3f(c, -448.f, 448.f); d = __builtin_amdgcn_fmed3f(d, -448.f, 448.f);
    int w = 0; w = __builtin_amdgcn_cvt_pk_fp8_f32(a, b, w, false); w = __builtin_amdgcn_cvt_pk_fp8_f32(c, d, w, true); return (unsigned)w; }
DI float bflo(unsigned u) { return __uint_as_float(u << 16); }
DI float bfhi(unsigned u) { return __uint_as_float(u & 0xffff0000u); }
DI float bf2f(bf16 b) { return __uint_as_float(((unsigned)b) << 16); }
DI u32x4 pack8(const f32x4& a, const f32x4& b) { u32x4 w; w.x = pk2(a.x, a.y); w.y = pk2(a.z, a.w); w.z = pk2(b.x, b.y); w.w = pk2(b.z, b.w); return w; }
DI void unpack8(const u32x4& w, f32x4& a, f32x4& b) { a = (f32x4){bflo(w.x), bfhi(w.x), bflo(w.y), bfhi(w.y)}; b = (f32x4){bflo(w.z), bfhi(w.z), bflo(w.w), bfhi(w.w)}; }
DI float fexp2(float x) { return __builtin_amdgcn_exp2f(x); }
DI float frcp(float x) { return __builtin_amdgcn_rcpf(x); }
DI float flog2(float x) { return __builtin_amdgcn_logf(x); }
DI float frsq(float x) { return __builtin_amdgcn_rsqf(x); }
constexpr float LOG2E = 1.4426950408889634f, LN2 = 0.6931471805599453f;
DI float fsigmoid(float x) { return frcp(1.0f + fexp2(-x * LOG2E)); }
DI float fsilu(float x) { return x * fsigmoid(x); }
DI float flogsigmoid(float x) { return fminf(x, 0.f) - LN2 * flog2(1.0f + fexp2(-fabsf(x) * LOG2E)); }
#define LDS_WAIT() asm volatile("s_waitcnt lgkmcnt(0)" ::: "memory")
#define VM_WAIT() asm volatile("s_waitcnt vmcnt(0)" ::: "memory")

constexpr int NB = 4, SEQ = 8192, T = NB * SEQ, D = 2048;
constexpr int IN_COLS = 7184;
constexpr int ZC = 7424, GC = 6144, NIN = ZC + GC;
constexpr int ZU = 0, ZSQ = 1024, ZSK = 2048, ZSV = 3072, ZGQ = 4096, ZGK = 4608, ZGV = 5120, ZGR = 6144, ZLR = 7168;
constexpr int DFF = 5632, NE = 8, PLE = 256;
constexpr float EPS = 1e-6f;
constexpr int NWAVES = 8, NTHR = 512;
constexpr int SORT_ROWS = 2 * T + NE * 256, SORT_TILES = SORT_ROWS / 256;

constexpr size_t MiB = 1u << 20;
constexpr size_t WS_CTL = 0, CTL_ZERO_BYTES = 1 * MiB;
constexpr size_t WS_MISC = 1 * MiB;
constexpr size_t MISC_SEL = 0, MISC_SELW = 128 * 1024, MISC_SLOT = 384 * 1024, MISC_CNT = 640 * 1024, MISC_ROWW = 648 * 1024, MISC_TILE = 920 * 1024, MISC_ROWTOK = 1024 * 1024  ;
constexpr size_t WS_DBUF = 3 * MiB;
constexpr size_t WS_W = 4 * MiB;
constexpr size_t WL_WIN = 0, WL_WBG8 = 29 * MiB  , WL_POOL = 53 * MiB, WL_WUP = WL_POOL + MiB / 2, WL_WO = WL_WUP + 12 * MiB, WL_PLEP = WL_WO + 8 * MiB, WL_PLEG = WL_PLEP + 1 * MiB, WL_SIZE = WL_PLEG + 8 * MiB;
constexpr size_t WS_FFN13 = WS_W + 2 * WL_SIZE, WS_FFN2 = WS_FFN13 + 44 * MiB, WS_PB = WS_FFN2 + 22 * MiB;
constexpr size_t WS_HB = WS_PB + 32 * MiB;
constexpr size_t WS_PP = WS_HB + 128 * MiB;
constexpr size_t WS_BR = WS_PP + 128 * MiB;
constexpr size_t WS_Z = WS_BR, WS_GATES = WS_Z + 464 * MiB, WS_POOLED = WS_GATES + 384 * MiB, WS_SVT = WS_POOLED + 64 * MiB, WS_GVT = WS_SVT + 64 * MiB, WS_SBUF = WS_GVT + 64 * MiB;
constexpr size_t WS_ACT = WS_BR;
constexpr size_t WS_WMOE = WS_BR, WMOE_E = 33 * MiB, WMOE_W2 = 22 * MiB;
constexpr size_t WS_ASORT = WS_WMOE + 264 * MiB, WS_ACTS = WS_ASORT + 132 * MiB, WS_YSORT = WS_ACTS + 363 * MiB;
constexpr size_t WS_END = WS_BR + 1174 * MiB;
static_assert(WL_SIZE == 82 * MiB + MiB / 2, "layer weight block");
static_assert(WS_SBUF + 128 * MiB <= WS_END, "mixer region inside the MoE region's extent");
static_assert((size_t)T * ZC * 2 == 464 * MiB && (size_t)T * GC * 2 == 384 * MiB && (size_t)SORT_ROWS * DFF == 363 * MiB && (size_t)SORT_ROWS * D == 132 * MiB && WS_YSORT + (size_t)SORT_ROWS * D * 2 <= WS_END, "sizes");
constexpr int CW_TMO = 0, CW_BAR = 4096;
constexpr size_t CTL_SS0 = 256 * 1024, CTL_SS1 = 512 * 1024;
constexpr float SSQ_FIX = 16777216.0f, SSQ_UNFIX = 1.0f / 16777216.0f;

constexpr int RING_BYTES = 131072;
constexpr int MISC_OFF = RING_BYTES;
constexpr int JUNK_OFF = RING_BYTES + 1024;
constexpr int LDS_BYTES = RING_BYTES + 1024 + 2048;

namespace pg8 {
constexpr int BM = 256, BK = 64, HALF = 128, HTB = HALF * BK * 2, NXCD = 8, WGM = 4;
__host__ __device__ __forceinline__ int lds_byte(int r, int c) { const int st = (r >> 4) * 2 + (c >> 5), rr = r & 15, cc = c & 31, ob = rr * 64 + cc * 2; return st * 1024 + (ob ^ (((ob >> 9) & 1) << 5)); }
__host__ __device__ __forceinline__ void stage_rc(int b, int& R, int& C) { const int st = b / 1024, sb = b % 1024, swz = sb ^ (((sb >> 9) & 1) << 5); R = (st >> 1) * 16 + swz / 64; C = (st & 1) * 32 + (swz % 64) / 2; }
__host__ __device__ __forceinline__ int perm32(int rho) { const int n = rho >> 4, i = rho & 15; return 8 * (i >> 2) + 4 * n + (i & 3); }
struct Unit { int pm, pn, aux; };
struct StaticOrder {
    int nM, nN, nwg, G, c;
    __device__ void init(int nM_, int nN_, int G_, int c_) { nM = nM_; nN = nN_; nwg = nM * nN; G = G_; c = c_; }
    __device__ bool tile(int i, int& pm, int& pn) const {
        const long L = (long)i * G + c; if (L >= nwg) return false;
        int wgid = (int)L; { const int q = nwg / NXCD, r = nwg % NXCD, xcd = wgid % NXCD, off = wgid / NXCD; wgid = (xcd < r ? xcd * (q + 1) : r * (q + 1) + (xcd - r) * q) + off; }
        const int nig = WGM * nN, gid = wgid / nig, fm = gid * WGM, gsz = (nM - fm) < WGM ? (nM - fm) : WGM;
        pm = fm + ((wgid % nig) % gsz); pn = (wgid % nig) / gsz; return true;
    }
};
template <class P>
__device__ __forceinline__ void gemm_phase(LAS unsigned char* lds, const P& S) {
    int tid_ = threadIdx.x; asm volatile("" : "+v"(tid_));
    const int tid = tid_, wid = __builtin_amdgcn_readfirstlane(tid >> 6), lane = tid & 63, wr = wid >> 2, wc = wid & 3, fr = lane & 15, fq = lane >> 4;
    const int K = S.K, nt = K / BK;
    unsigned voffA[2], voffB[2];
#pragma unroll
    for (int i = 0; i < 2; ++i) { int R, C; stage_rc(tid * 16 + i * 8192, R, C); const int Rb = P::PERM ? ((R & ~31) + perm32(R & 31)) : R;
        voffA[i] = (unsigned)(R * S.lda + C) * 2u; voffB[i] = (unsigned)(Rb * S.ldb + C) * 2u; }
    unsigned gcur[2][2] = {{0u, 0u}, {0u, 0u}}, gnxt[2][2] = {{0u, 0u}, {0u, 0u}};
    const size_t kstep = (size_t)(BK * 2);
    const size_t hstepA = (size_t)HALF * S.lda * 2, hstepB = (size_t)HALF * S.ldb * 2;
    const unsigned ldsw = (unsigned)wid * 1024u;
    const int aoff = lds_byte(wr * 64 + fr, fq * 8), boff = lds_byte(wc * 32 + fr, fq * 8);
#define PG8_SA(b, h) (((b) * 2 + (h)) * HTB)
#define PG8_SB(b, h) ((4 + (b) * 2 + (h)) * HTB)
#define PG8_STAGE(bufoff, gbase, voff) do { _Pragma("unroll") for (int _i = 0; _i < 2; ++_i) \
        __builtin_amdgcn_global_load_lds((const unsigned*)((const char*)(gbase) + (voff)[_i]), (LAS unsigned*)(lds + (bufoff) + ldsw + _i * 8192), 16, 0, 0); } while (0)
#define PG8_STAGE_A(bufoff, gptr, h, isnext) do { if constexpr (P::GATHER) { _Pragma("unroll") for (int _i = 0; _i < 2; ++_i) \
        __builtin_amdgcn_global_load_lds((const unsigned*)((const char*)(gptr) + ((isnext) ? gnxt[h][_i] : gcur[h][_i])), (LAS unsigned*)(lds + (bufoff) + ldsw + _i * 8192), 16, 0, 0); } \
        else { PG8_STAGE(bufoff, (gptr) + ((h) ? hstepA : 0), voffA); } } while (0)
#define PG8_LDA(dst, b, h) do { _Pragma("unroll") for (int m = 0; m < 4; ++m) _Pragma("unroll") for (int k = 0; k < 2; ++k) dst[m][k] = *(const LAS bf16x8*)(lds + PG8_SA(b, h) + aoff + m * 2048 + k * 1024); } while (0)
#define PG8_LDB(dst, b, h) do { _Pragma("unroll") for (int n = 0; n < 2; ++n) _Pragma("unroll") for (int k = 0; k < 2; ++k) dst[n][k] = *(const LAS bf16x8*)(lds + PG8_SB(b, h) + boff + n * 2048 + k * 1024); } while (0)
#define PG8_CAT(x) __builtin_shufflevector(__builtin_bit_cast(i32x4, (x)[0]), __builtin_bit_cast(i32x4, (x)[1]), 0, 1, 2, 3, 4, 5, 6, 7)
#define PG8_MMA(ai, bj, At, Bt) do { __builtin_amdgcn_s_setprio(1); _Pragma("unroll") for (int m = 0; m < 4; ++m) _Pragma("unroll") for (int n = 0; n < 2; ++n) { \
        if constexpr (P::FP8) { const i32x8 b8_ = PG8_CAT(Bt[n]), a8_ = PG8_CAT(At[m]); \
            asm volatile("v_mfma_scale_f32_16x16x128_f8f6f4 %0, %1, %2, %0, %3, %4 op_sel_hi:[0,0,0]" : "+v"(acc[ai][bj][m][n]) : "v"(b8_), "v"(a8_), "v"(sclB), "v"(sclA)); } \
        else if constexpr (P::SWAPMM) { _Pragma("unroll") for (int k = 0; k < 2; ++k) acc[ai][bj][m][n] = __builtin_amdgcn_mfma_f32_16x16x32_bf16(At[m][k], Bt[n][k], acc[ai][bj][m][n], 0, 0, 0); } \
        else { _Pragma("unroll") for (int k = 0; k < 2; ++k) acc[ai][bj][m][n] = __builtin_amdgcn_mfma_f32_16x16x32_bf16(Bt[n][k], At[m][k], acc[ai][bj][m][n], 0, 0, 0); } } \
        __builtin_amdgcn_s_setprio(0); } while (0)
#define PG8_WAIT_V(n) asm volatile("s_waitcnt vmcnt(" #n ")" ::: "memory")
#define PG8_WAIT_L(n) asm volatile("s_waitcnt lgkmcnt(" #n ")" ::: "memory")
#define PG8_BAR __builtin_amdgcn_s_barrier()
#define PG8_SCHED __builtin_amdgcn_sched_barrier(0)
    Unit cur, nxt; int ui = 0;
    if (!S.next(0, cur)) return;
    int sclA = 0x7f7f7f7f, sclB = P::BSCALE; asm volatile("" : "+v"(sclA), "+v"(sclB));
    f32x4 acc[2][2][4][2];
#pragma unroll
    for (int a = 0; a < 2; ++a)
#pragma unroll
        for (int b = 0; b < 2; ++b)
#pragma unroll
            for (int m = 0; m < 4; ++m)
#pragma unroll
                for (int n = 0; n < 2; ++n) acc[a][b][m][n] = (f32x4){0.f, 0.f, 0.f, 0.f};
    bf16x8 At[4][2], B0[2][2], B1[2][2];
    const char* cA = S.a_base(cur); const char* cB = S.b_base(cur);
    if constexpr (P::GATHER) {
#pragma unroll
        for (int h = 0; h < 2; ++h)
#pragma unroll
            for (int i = 0; i < 2; ++i) { int R, C; stage_rc(tid * 16 + i * 8192, R, C); gcur[h][i] = S.row_off(cur, R + 128 * h) + (unsigned)(C * 2); } }
    PG8_STAGE(PG8_SB(0, 0), cB, voffB); PG8_STAGE(PG8_SB(0, 1), cB + hstepB, voffB); PG8_STAGE_A(PG8_SA(0, 0), cA, 0, false); PG8_STAGE_A(PG8_SA(0, 1), cA, 1, false);
    if (wr == 1) PG8_BAR;
    PG8_WAIT_V(2); PG8_BAR;
    PG8_STAGE(PG8_SB(1, 0), cB + kstep, voffB); PG8_STAGE_A(PG8_SA(1, 0), cA + kstep, 0, false); PG8_STAGE(PG8_SB(1, 1), cB + hstepB + kstep, voffB);
    PG8_WAIT_V(6); PG8_BAR;
    for (;;) {
        const bool has_next = S.next(ui + 1, nxt);
        const char* nA = has_next ? S.a_base(nxt) : cA; const char* nB = has_next ? S.b_base(nxt) : cB;
        if constexpr (P::GATHER) {
#pragma unroll
            for (int h = 0; h < 2; ++h)
#pragma unroll
                for (int i = 0; i < 2; ++i) { int R, C; stage_rc(tid * 16 + i * 8192, R, C); gnxt[h][i] = has_next ? S.row_off(nxt, R + 128 * h) + (unsigned)(C * 2) : gcur[h][i]; } }
        for (int t = 0; t < nt; t += 2) {
            const bool last = (t == nt - 2);
            const char* a1 = cA + (size_t)(t + 1) * kstep;
            const char* a2 = last ? nA : cA + (size_t)(t + 2) * kstep; const char* b2 = last ? nB : cB + (size_t)(t + 2) * kstep;
            const char* a3 = a2 + kstep; const char* b3 = b2 + kstep;
            PG8_LDB(B0, 0, 0); PG8_LDB(B1, 0, 1); PG8_SCHED; PG8_LDA(At, 0, 0); PG8_STAGE_A(PG8_SA(1, 1), a1, 1, false);
            PG8_WAIT_V(8); PG8_WAIT_L(0); PG8_BAR; PG8_MMA(0, 0, At, B0); PG8_MMA(0, 1, At, B1); PG8_BAR; PG8_SCHED;
            PG8_LDA(At, 0, 1); PG8_STAGE(PG8_SB(0, 0), b2, voffB); PG8_STAGE(PG8_SB(0, 1), b2 + hstepB, voffB); PG8_STAGE_A(PG8_SA(0, 0), a2, 0, last);
            PG8_WAIT_V(8); PG8_WAIT_L(0); PG8_BAR; PG8_MMA(1, 0, At, B0); PG8_MMA(1, 1, At, B1); PG8_BAR; PG8_SCHED;
            PG8_LDB(B0, 1, 0); PG8_LDB(B1, 1, 1); PG8_SCHED; PG8_LDA(At, 1, 0); PG8_STAGE_A(PG8_SA(0, 1), a2, 1, last);
            PG8_WAIT_V(8); PG8_WAIT_L(0); PG8_BAR; PG8_MMA(0, 0, At, B0); PG8_MMA(0, 1, At, B1); PG8_BAR; PG8_SCHED;
            PG8_LDA(At, 1, 1); PG8_STAGE(PG8_SB(1, 0), b3, voffB); PG8_STAGE(PG8_SB(1, 1), b3 + hstepB, voffB); PG8_STAGE_A(PG8_SA(1, 0), a3, 0, last);
            PG8_WAIT_V(8); PG8_WAIT_L(0); PG8_BAR; PG8_MMA(1, 0, At, B0); PG8_MMA(1, 1, At, B1); PG8_BAR; PG8_SCHED;
        }
        if constexpr (P::PREFETCH) S.pre_epi(cur, wid, lane, lds);
        if (wr == 0) PG8_BAR;
        if constexpr (P::FP8) asm volatile("s_nop 15\n\ts_nop 15\n\ts_nop 7" ::: "memory");
        const bool zero = S.epi(acc, cur, wr, wc, fr, fq);
        if (!has_next) break;
        if (zero) {
#pragma unroll
        for (int a = 0; a < 2; ++a)
#pragma unroll
            for (int b = 0; b < 2; ++b)
#pragma unroll
                for (int m = 0; m < 4; ++m)
#pragma unroll
                    for (int n = 0; n < 2; ++n) acc[a][b][m][n] = (f32x4){0.f, 0.f, 0.f, 0.f};
        }
        cur = nxt; cA = nA; cB = nB; ++ui;
        if constexpr (P::GATHER) {
#pragma unroll
            for (int h = 0; h < 2; ++h)
#pragma unroll
                for (int i = 0; i < 2; ++i) gcur[h][i] = gnxt[h][i]; }
        if (wr == 1) PG8_BAR;
    }
    PG8_WAIT_V(0);
    PG8_BAR;
#undef PG8_SA
#undef PG8_SB
#undef PG8_STAGE
#undef PG8_LDA
#undef PG8_STAGE_A
#undef PG8_LDB
#undef PG8_MMA
#undef PG8_CAT
#undef PG8_WAIT_V
#undef PG8_WAIT_L
#undef PG8_BAR
#undef PG8_SCHED
}
}

#define XB_TMO      128
#define XB_XCNT(j)  (256  + 64 * (j))
#define XB_XSUB(j)  (1280 + 64 * (j))
#define XB_XGEN(j)  (2304 + 64 * (j))
#define XB_TOP      3328
#define XB_TOPGEN   3392
#define XCD_BAR_WORDS 3456
#define XB_SPIN_CAP (1u << 20)
__device__ __forceinline__ unsigned xb_ld(unsigned* p)              { return __hip_atomic_load(p, __ATOMIC_RELAXED, __HIP_MEMORY_SCOPE_AGENT); }
__device__ __forceinline__ unsigned xb_add(unsigned* p, unsigned v) { return __hip_atomic_fetch_add(p, v, __ATOMIC_RELAXED, __HIP_MEMORY_SCOPE_AGENT); }
__device__ __forceinline__ unsigned xb_xcc_id() { return (unsigned)__builtin_amdgcn_s_getreg((3 << 11) | 20) & 0xFu; }
#define XB_SPIN(cond, bar) do { unsigned _sp = 0; while (cond) { __builtin_amdgcn_s_sleep(1); \
    if ((++_sp & 255u) == 0u) { if (xb_ld(&(bar)[XB_TMO])) break; if (_sp > XB_SPIN_CAP) { atomicAdd(&(bar)[XB_TMO], 1u); break; } } } } while (0)
struct XcdBarrier { unsigned* bar; unsigned x; volatile LAS unsigned* st; };
__device__ __forceinline__ XcdBarrier xcd_barrier_post(unsigned* bar, volatile LAS unsigned* st) {
    XcdBarrier b; b.bar = bar; b.x = xb_xcc_id(); b.st = st;
    if (threadIdx.x == 0) (void)xb_add(&bar[XB_XCNT(b.x)], 1u);
    return b;
}
__device__ __forceinline__ void xcd_barrier_complete(unsigned* bar, unsigned x, unsigned& nloc, unsigned& nx) {
    const unsigned G = gridDim.x * gridDim.y * gridDim.z;
    unsigned sum, cnt, mine, sp = 0u;
    for (;;) {
        sum = 0u; cnt = 0u; mine = 0u;
#pragma unroll
        for (unsigned j = 0; j < 16; ++j) { const unsigned c = xb_ld(&bar[XB_XCNT(j)]); sum += c; cnt += (c > 0u) ? 1u : 0u; mine = (j == x) ? c : mine; }
        if (sum == G) break;
        __builtin_amdgcn_s_sleep(1);
        if ((++sp & 255u) == 0u) { if (xb_ld(&bar[XB_TMO])) break; if (sp > XB_SPIN_CAP) { atomicAdd(&bar[XB_TMO], 1u); break; } }
    }
    nloc = mine > 0u ? mine : 1u; nx = cnt > 0u ? cnt : 1u;
}
__device__ __forceinline__ void xcd_barrier(const XcdBarrier& b) {
    asm volatile("s_waitcnt vmcnt(0)" ::: "memory");
    __syncthreads();
    if (threadIdx.x == 0) {
        unsigned* bar = b.bar; asm volatile("" : "+s"(bar));
        __builtin_amdgcn_s_waitcnt(0);
        unsigned nloc = b.st[0], nx = b.st[1];
        if (nloc == 0u) { xcd_barrier_complete(bar, b.x, nloc, nx); b.st[0] = nloc; b.st[1] = nx; }
        const unsigned old = xb_add(&bar[XB_XSUB(b.x)], 1u);
        const unsigned gen = old / nloc;
        if (old + 1u == (gen + 1u) * nloc) {
            __builtin_amdgcn_fence(__ATOMIC_RELEASE, "agent");
            asm volatile("s_waitcnt vmcnt(0)" ::: "memory");
            const unsigned og = xb_add(&bar[XB_TOP], 1u);
            const unsigned tg = og / nx;
            if (og + 1u == (tg + 1u) * nx) xb_add(&bar[XB_TOPGEN], 1u);
            else XB_SPIN(xb_ld(&bar[XB_TOPGEN]) == tg, bar);
            __builtin_amdgcn_fence(__ATOMIC_ACQUIRE, "agent");
            xb_add(&bar[XB_XGEN(b.x)], 1u);
            asm volatile("s_waitcnt vmcnt(0)" ::: "memory");
        } else {
            XB_SPIN(xb_ld(&bar[XB_XGEN(b.x)]) == gen, bar);
            __builtin_amdgcn_fence(__ATOMIC_ACQUIRE, "agent");
            asm volatile("s_waitcnt vmcnt(0)" ::: "memory");
        }
    }
    __syncthreads();
}

struct Args { const float* in[27]; float* out; unsigned char* ws; int ph_lo, ph_hi; };
enum { I_X = 0, I_P, I_GMIX, I_WIN, I_WBG, I_BBG, I_POOLW, I_POOLS, I_SBGQ, I_SBGK, I_GLAWLR, I_GLABLR, I_GLAGOUT, I_WUPP, I_WUPS, I_WUPG, I_WO, I_GFFN,
       I_FW1, I_FW3, I_FW2, I_ROUTER, I_MW1, I_MW3, I_MW2, I_PLEP, I_PLEG };
struct Frame {
    LAS unsigned char* lds;
    int tid, lane, wave, G, vcu, gw, ngw;
};
DI Frame fresh(const Frame& F0) {
    Frame F = F0; int t = F0.tid; asm volatile("" : "+v"(t)); F.tid = t; F.lane = t & 63; F.wave = __builtin_amdgcn_readfirstlane(t >> 6); F.gw = F.vcu * NWAVES + F.wave; return F;
}
DI float wave_sum(float v) {
#pragma unroll
    for (int o = 1; o < 64; o <<= 1) v += __shfl_xor(v, o);
    return v;
}

DI int map_row(int kind, int n, int row_off) {
    if (kind == 1) return n < 6144 ? n : (n < 6160 ? ZLR + (n - 6144) : ZGR + (n - 6160));
    if (kind == 2) return (n >> 7) * 256 + (n & 127);
    if (kind == 3) return (n >> 7) * 256 + 128 + (n & 127);
    return n + row_off;
}
template <bool F8> DI void transpose_item(const float* __restrict__ W, int K, int N, bf16* WT, int kind, int row_off, LAS float* scr, int item, int lane, const float* gk = nullptr) {
    const int nblk = (N + 31) / 32, kb = item / nblk, nb = item % nblk, k0 = 64 * kb, n0 = 32 * nb;
    const int nc = n0 + 4 * (lane & 7);
    f32x4 v[8];
#pragma unroll
    for (int j = 0; j < 8; ++j) v[j] = nc < N ? *(const f32x4*)(W + (size_t)(k0 + 8 * j + (lane >> 3)) * N + nc) : (f32x4){0.f, 0.f, 0.f, 0.f};
    if (gk) {
#pragma unroll
        for (int j = 0; j < 8; ++j) v[j] = v[j] * gk[k0 + 8 * j + (lane >> 3)]; }
#pragma unroll
    for (int j = 0; j < 8; ++j) { LAS float* d = scr + (8 * j + (lane >> 3)) * 33 + 4 * (lane & 7); d[0] = v[j].x; d[1] = v[j].y; d[2] = v[j].z; d[3] = v[j].w; }
    LDS_WAIT(); asm volatile("" ::: "memory");
    const int c = lane & 7;
#pragma unroll
    for (int j = 0; j < 4; ++j) { const int nl = (lane >> 3) + 8 * j; const LAS float* s = scr + (8 * c) * 33 + nl;
        if constexpr (F8) {
            u32x2 o; o.x = pk4_fp8(64.f * s[0 * 33], 64.f * s[1 * 33], 64.f * s[2 * 33], 64.f * s[3 * 33]); o.y = pk4_fp8(64.f * s[4 * 33], 64.f * s[5 * 33], 64.f * s[6 * 33], 64.f * s[7 * 33]);
            if (n0 + nl < N) *(u32x2*)((unsigned char*)WT + (size_t)map_row(kind, n0 + nl, row_off) * K + k0 + 8 * c) = o;
        } else {
        u32x4 o; o.x = pk2(s[0 * 33], s[1 * 33]); o.y = pk2(s[2 * 33], s[3 * 33]); o.z = pk2(s[4 * 33], s[5 * 33]); o.w = pk2(s[6 * 33], s[7 * 33]);
        if (n0 + nl < N) *(u32x4*)(WT + (size_t)map_row(kind, n0 + nl, row_off) * K + k0 + 8 * c) = o; } }
    LDS_WAIT(); asm volatile("" ::: "memory");
}
template <bool F8 = false> DI void convert_matrix(const Frame& F0, const float* W, int K, int N, bf16* WT, int kind, int row_off, int rot, int scr_off = -1, const float* gk = nullptr) {
    const Frame F = fresh(F0);
    LAS float* scr = (LAS float*)(F.lds + (scr_off >= 0 ? scr_off : F.wave * 16384));
    const int nitems = (K / 64) * ((N + 31) / 32);
    int g0 = F.gw - (rot % F.ngw); if (g0 < 0) g0 += F.ngw;
    for (int it = g0; it < nitems; it += F.ngw) transpose_item<F8>(W, K, N, WT, kind, row_off, scr, it, F.lane, gk);
}

template <bool F8, bool XIN16> DI void rms_row(const void* xrow, const float* g, bf16* hrow, bf16* xcopy, int lane, f32x4 (&v)[8], float& rstd, unsigned char* h8row = nullptr) {
    float ss = 0.f;
#pragma unroll
    for (int j = 0; j < 8; ++j) { if constexpr (XIN16) { const u32x2 w = ((const u32x2*)xrow)[lane + 64 * j]; v[j] = (f32x4){bflo(w.x), bfhi(w.x), bflo(w.y), bfhi(w.y)}; } else v[j] = ((const f32x4*)xrow)[lane + 64 * j]; ss += (v[j].x * v[j].x + v[j].y * v[j].y) + (v[j].z * v[j].z + v[j].w * v[j].w); }
    rstd = frsq(wave_sum(ss) * (1.f / D) + EPS);
    u32x2* o8 = (u32x2*)hrow + lane;
#pragma unroll
    for (int j = 0; j < 8; ++j) { const f32x4 gg = ((const f32x4*)g)[lane + 64 * j]; if (xcopy) { u32x2 w; w.x = pk2(v[j].x, v[j].y); w.y = pk2(v[j].z, v[j].w); ((u32x2*)xcopy)[lane + 64 * j] = w; }
        v[j] = v[j] * rstd * gg;
        if constexpr (F8) ((unsigned*)hrow)[lane + 64 * j] = pk4_fp8(v[j].x, v[j].y, v[j].z, v[j].w);
        else { u32x2 w; w.x = pk2(v[j].x, v[j].y); w.y = pk2(v[j].z, v[j].w); o8[64 * j] = w; if (h8row) ((unsigned*)h8row)[lane + 64 * j] = pk4_fp8(v[j].x, v[j].y, v[j].z, v[j].w); } }
}
template <bool F8, bool XIN16> DI void phase_rmsnorm(const Frame& F0, const void* X, const float* g, bf16* HB, bf16* xcopy, unsigned char* H8 = nullptr) {
    const Frame F = fresh(F0);
    for (int m = F.gw; m < T; m += F.ngw) { f32x4 v[8]; float rstd; rms_row<F8, XIN16>((const char*)X + (size_t)m * D * (XIN16 ? 2 : 4), g, F8 ? (bf16*)((unsigned char*)HB + (size_t)m * D) : HB + (size_t)m * D, xcopy ? xcopy + (size_t)m * D : nullptr, F.lane, v, rstd, H8 ? H8 + (size_t)m * D : nullptr); }
}
DI void phase_rmsnorm_route(const Frame& F0, const bf16* X, const float* g, bf16* HB, const float* router, int* sel, float* selw, int* cnt, const float* mw1, const float* mw3, const float* mw2, unsigned char* wmoe) {
    const Frame F = fresh(F0);
    LAS float* rl = (LAS float*)F.lds;
    LAS int* sl = (LAS int*)(F.lds + 65536);
    for (int i = F.tid; i < D * NE / 4; i += NTHR) { const f32x4 r = ((const f32x4*)router)[i]; const int col = i >> 1, e0 = 4 * (i & 1);
        rl[(e0 + 0) * D + col] = r.x; rl[(e0 + 1) * D + col] = r.y; rl[(e0 + 2) * D + col] = r.z; rl[(e0 + 3) * D + col] = r.w; }
    __syncthreads();
    const int c = blockIdx.x;
#pragma unroll 1
    for (int half = 0; half < 2; ++half) {
    if ((F.wave >> 2) != half) {
        int rot = 0; const int scr_off = 66560 + (F.wave & 3) * 8448;
        for (int rep = 0; rep < ((DUP_MASK & 2) ? 2 : 1); ++rep)
        for (int e = 0; e < NE; ++e) {
            unsigned char* we = wmoe + (size_t)e * WMOE_E;
            convert_matrix<true>(F, mw1 + (size_t)e * D * DFF, D, DFF, (bf16*)we, 2, 0, rot, scr_off); rot += 32 * 176;
            convert_matrix<true>(F, mw3 + (size_t)e * D * DFF, D, DFF, (bf16*)we, 3, 0, rot, scr_off); rot += 32 * 176;
            convert_matrix<true>(F, mw2 + (size_t)e * DFF * D, DFF, D, (bf16*)(we + WMOE_W2), 0, 0, rot, scr_off); rot += 88 * 64;
        }
    } else
    for (int i = 0; i < 16; ++i) {
        const int lr = F.wave * 16 + i, m = c * 128 + lr;
        f32x4 v[8]; float rstd; rms_row<true, true>(X + (size_t)m * D, g, (bf16*)((unsigned char*)HB + (size_t)m * D), nullptr, F.lane, v, rstd);
        float lg[NE];
#pragma unroll
        for (int e = 0; e < NE; ++e) lg[e] = 0.f;
#pragma unroll
        for (int e = 0; e < NE; ++e)
#pragma unroll
            for (int j = 0; j < 8; ++j) { const f32x4 r = *(const LAS f32x4*)(rl + e * D + 4 * F.lane + 256 * j); lg[e] += (v[j].x * r.x + v[j].y * r.y) + (v[j].z * r.z + v[j].w * r.w); }
#pragma unroll
        for (int e = 0; e < NE; ++e) lg[e] = wave_sum(lg[e]);
        int e1 = 0; float v1 = lg[0];
#pragma unroll
        for (int e = 1; e < NE; ++e) if (lg[e] > v1) { v1 = lg[e]; e1 = e; }
        int e2 = -1; float v2 = -3.0e38f;
#pragma unroll
        for (int e = 0; e < NE; ++e) if (e != e1 && lg[e] > v2) { v2 = lg[e]; e2 = e; }
        const float w1 = frcp(1.0f + fexp2((v2 - v1) * LOG2E)), w2 = 1.0f - w1;
        if (F.lane == 0) { sel[m] = e1 | (e2 << 8); selw[2 * m] = w1; selw[2 * m + 1] = w2; sl[lr] = e1 | (e2 << 8); }
    }
    __syncthreads();
    }
    if (F.tid < NE) { int n = 0; for (int i = 0; i < 128; ++i) { const int s = sl[i]; n += ((s & 255) == F.tid) + ((s >> 8) == F.tid); } cnt[c * NE + F.tid] = n; }
    __syncthreads();
}

DI void phase_postproj(const Frame& F0, bf16* Z, const float* gq, const float* gk, bf16* POOLED, bf16* SVT, bf16* GVT, bool do_norm, bool do_rest, bf16* ndst, int ndld) {
    const Frame F = fresh(F0);
    if (do_norm) for (int m = F.gw; m < T; m += F.ngw) {
        const u32x4* row = (const u32x4*)(Z + (size_t)m * ZC + ZSQ); u32x4* drow = (u32x4*)(ndst + (size_t)m * ndld);
#pragma unroll
        for (int j = 0; j < 4; ++j) {
            const int ch = F.lane + 64 * j; u32x4 w = row[ch];
            float f[8] = {bflo(w.x), bfhi(w.x), bflo(w.y), bfhi(w.y), bflo(w.z), bfhi(w.z), bflo(w.w), bfhi(w.w)};
            float ss = 0.f;
#pragma unroll
            for (int q = 0; q < 8; ++q) ss += f[q] * f[q];
            ss += __shfl_xor(ss, 1); ss += __shfl_xor(ss, 2); ss += __shfl_xor(ss, 4); ss += __shfl_xor(ss, 8);
            float sc = frsq(ss * (1.f / 128.f) + EPS); if (j < 2) sc *= 0.08838834764831845f * LOG2E;
            const float* gg = (j < 2 ? gq : gk) + (ch & 15) * 8;
            const f32x4 g0 = *(const f32x4*)gg, g1 = *(const f32x4*)(gg + 4);
            w.x = pk2(f[0] * sc * g0.x, f[1] * sc * g0.y); w.y = pk2(f[2] * sc * g0.z, f[3] * sc * g0.w); w.z = pk2(f[4] * sc * g1.x, f[5] * sc * g1.y); w.w = pk2(f[6] * sc * g1.z, f[7] * sc * g1.w);
            drow[ch] = w;
        }
    }
    if (do_rest) for (int it = F.gw * 64 + F.lane; it < (T / 16) * 128; it += F.ngw * 64) {
        const int tile = it >> 7, ch = it & 127, c0 = ch * 8, g = c0 >> 8, w = 2 << g, t0 = tile * 16, s0 = t0 & (SEQ - 1);
        float win[8];
#pragma unroll
        for (int q = 0; q < 8; ++q) win[q] = 0.f;
        for (int j = 1; j < w; ++j) { if (s0 - j >= 0) { const u32x4 u = *(const u32x4*)(Z + (size_t)(t0 - j) * ZC + ZU + c0);
                win[0] += bflo(u.x); win[1] += bfhi(u.x); win[2] += bflo(u.y); win[3] += bfhi(u.y); win[4] += bflo(u.z); win[5] += bfhi(u.z); win[6] += bflo(u.w); win[7] += bfhi(u.w); } }
        for (int i = 0; i < 16; ++i) {
            const int s = s0 + i; const u32x4 u = *(const u32x4*)(Z + (size_t)(t0 + i) * ZC + ZU + c0);
            const float f[8] = {bflo(u.x), bfhi(u.x), bflo(u.y), bfhi(u.y), bflo(u.z), bfhi(u.z), bflo(u.w), bfhi(u.w)};
#pragma unroll
            for (int q = 0; q < 8; ++q) win[q] += f[q];
            const float inv = 1.0f / (float)(s + 1 < w ? s + 1 : w);
            u32x4 o; o.x = pk2(win[0] * inv - f[0], win[1] * inv - f[1]); o.y = pk2(win[2] * inv - f[2], win[3] * inv - f[3]); o.z = pk2(win[4] * inv - f[4], win[5] * inv - f[5]); o.w = pk2(win[6] * inv - f[6], win[7] * inv - f[7]);
            *(u32x4*)(POOLED + (size_t)(t0 + i) * 1024 + c0) = o;
            if (s - w + 1 >= 0) { const u32x4 d = *(const u32x4*)(Z + (size_t)(t0 + i - w + 1) * ZC + ZU + c0);
                win[0] -= bflo(d.x); win[1] -= bfhi(d.x); win[2] -= bflo(d.y); win[3] -= bfhi(d.y); win[4] -= bflo(d.z); win[5] -= bfhi(d.z); win[6] -= bflo(d.w); win[7] -= bfhi(d.w); }
        }
    }
    LAS bf16* scr = (LAS bf16*)(F.lds + F.wave * 9216);
    if (false) for (int it = F.gw; it < 2 * (T / 64) * 16; it += F.ngw) {
        const int which = it / ((T / 64) * 16), r = it % ((T / 64) * 16), tt = r >> 4, cb = r & 15, t0 = tt * 64, c0 = cb * 64;
        const bf16* src = Z + (size_t)t0 * ZC + (which ? ZGV : ZSV) + c0; bf16* dst = which ? GVT : SVT;
#pragma unroll
        for (int j = 0; j < 8; ++j) { const int idx = F.lane + 64 * j, tok = idx >> 3, cc = (idx & 7) * 8; const u32x4 u = *(const u32x4*)(src + (size_t)tok * ZC + cc);
            const unsigned uu[4] = {u.x, u.y, u.z, u.w};
#pragma unroll
            for (int q = 0; q < 4; ++q) { scr[(cc + 2 * q) * 72 + tok] = (bf16)(uu[q] & 0xffffu); scr[(cc + 2 * q + 1) * 72 + tok] = (bf16)(uu[q] >> 16); } }
        LDS_WAIT(); asm volatile("" ::: "memory");
        const int b = t0 / SEQ, s0 = t0 % SEQ;
#pragma unroll
        for (int j = 0; j < 8; ++j) { const int idx = F.lane + 64 * j, chn = idx >> 3, tk = (idx & 7) * 8; const u32x4 u = *(const LAS u32x4*)(scr + chn * 72 + tk);
            *(u32x4*)(dst + ((size_t)(b * 1024 + c0 + chn)) * SEQ + s0 + tk) = u; }
        LDS_WAIT(); asm volatile("" ::: "memory");
    }
}

template <bool GAIN> DI void norm_frag(bf16x8 (&f)[8], int hh, const LAS float* gl) {
    float ss = 0.f;
#pragma unroll
    for (int kk = 0; kk < 8; ++kk) { const u32x4 w = __builtin_bit_cast(u32x4, f[kk]);
        ss += (bflo(w.x) * bflo(w.x) + bfhi(w.x) * bfhi(w.x)) + (bflo(w.y) * bflo(w.y) + bfhi(w.y) * bfhi(w.y)) + (bflo(w.z) * bflo(w.z) + bfhi(w.z) * bfhi(w.z)) + (bflo(w.w) * bflo(w.w) + bfhi(w.w) * bfhi(w.w)); }
    ss += __shfl_xor(ss, 32);
    const float rstd = frsq(ss * (1.0f / 128.0f) + EPS);
#pragma unroll
    for (int kk = 0; kk < 8; ++kk) { f32x4 g0 = (f32x4){rstd, rstd, rstd, rstd}, g1 = g0;
        if constexpr (GAIN) { g0 = *(const LAS f32x4*)(gl + 16 * kk + 8 * hh) * rstd; g1 = *(const LAS f32x4*)(gl + 16 * kk + 8 * hh + 4) * rstd; }
        const u32x4 w = __builtin_bit_cast(u32x4, f[kk]); u32x4 o;
        o.x = pk2(bflo(w.x) * g0.x, bfhi(w.x) * g0.y); o.y = pk2(bflo(w.y) * g0.z, bfhi(w.y) * g0.w); o.z = pk2(bflo(w.z) * g1.x, bfhi(w.z) * g1.y); o.w = pk2(bflo(w.w) * g1.z, bfhi(w.w) * g1.w);
        f[kk] = __builtin_bit_cast(bf16x8, o); asm volatile("" : "+v"(f[kk])); }
}
DI void phase_sb(const Frame& F0, const bf16* Z, const bf16* SVT, bf16* outb, int ldo, int ocol, const float* gq, const float* gk) {
    const Frame F = fresh(F0);
    LAS float* gl = (LAS float*)F.lds;
    if (F.tid < 128) gl[F.tid] = gq[F.tid] * gk[F.tid] * (0.08838834764831845f * LOG2E);
    __syncthreads();
    const int lane = F.lane, tq = lane & 31, hh = lane >> 5;
    const int pi = 16 * ((tq >> 2) & 1) + 4 * (tq >> 3) + (tq & 3);
    for (int u = F.vcu; u < NB * 8 * (SEQ / 256); u += F.G) {
        const int qb = u & 31, bh = u >> 5, b = bh >> 3, h = bh & 7;
        const int t0 = qb * 256 + F.wave * 32;
        const size_t rowbase = (size_t)b * SEQ;
        bf16x8 qf[8];
        { const bf16* qp = Z + (rowbase + t0 + tq) * ZC + ZSQ + h * 128 + hh * 8;
#pragma unroll
          for (int kk = 0; kk < 8; ++kk) qf[kk] = *(const bf16x8*)(qp + kk * 16); }
        norm_frag<true>(qf, hh, gl);
        f32x16 o[4];
#pragma unroll
        for (int db = 0; db < 4; ++db)
#pragma unroll
            for (int r = 0; r < 16; ++r) o[db][r] = 0.f;
        float R = 1.f;
        const bf16* vbase = SVT + ((size_t)(b * 1024 + h * 128 + tq)) * SEQ + 16 * hh;
        for (int s0 = t0; s0 >= 0; s0 -= 32) {
            const bf16* kp = Z + (rowbase + s0 + pi) * ZC + ZSK + h * 128 + hh * 8;
            bf16x8 kf[8];
#pragma unroll
            for (int kk = 0; kk < 8; ++kk) kf[kk] = *(const bf16x8*)(kp + kk * 16);
            bf16x8 vf[4][2];
#pragma unroll
            for (int db = 0; db < 4; ++db)
#pragma unroll
                for (int j = 0; j < 2; ++j) vf[db][j] = *(const bf16x8*)(vbase + (size_t)db * 32 * SEQ + s0 + 8 * j);
            norm_frag<false>(kf, hh, gl);
            f32x16 s;
#pragma unroll
            for (int r = 0; r < 16; ++r) s[r] = 0.f;
#pragma unroll
            for (int kk = 0; kk < 8; ++kk) s = __builtin_amdgcn_mfma_f32_32x32x16_bf16(kf[kk], qf[kk], s, 0, 0, 0);
            const bool diag = (s0 == t0);
            float p[16]; float run = 1.f;
#pragma unroll
            for (int r = 15; r >= 0; --r) {
                const float e = fexp2(s[r]); float keep = frcp(1.0f + e), beta = 1.0f - keep;
                if (diag && (16 * hh + r >= tq)) { keep = 1.0f; beta = 0.f; }
                p[r] = beta * run; run *= keep;
            }
            const float other = __shfl_xor(run, 32);
            const float pref = hh ? R : R * other;
            R = R * run * other;
            bf16x8 pb[2];
#pragma unroll
            for (int j = 0; j < 2; ++j) { u32x4 w; w.x = pk2(p[8 * j] * pref, p[8 * j + 1] * pref); w.y = pk2(p[8 * j + 2] * pref, p[8 * j + 3] * pref); w.z = pk2(p[8 * j + 4] * pref, p[8 * j + 5] * pref); w.w = pk2(p[8 * j + 6] * pref, p[8 * j + 7] * pref);
                pb[j] = __builtin_bit_cast(bf16x8, w); }
#pragma unroll
            for (int db = 0; db < 4; ++db)
#pragma unroll
                for (int j = 0; j < 2; ++j) o[db] = __builtin_amdgcn_mfma_f32_32x32x16_bf16(vf[db][j], pb[j], o[db], 0, 0, 0);
            if (__all(R < 5.9604645e-8f)) break;
        }
        bf16* op = outb + (rowbase + t0 + tq) * ldo + ocol + h * 128 + 4 * hh;
#pragma unroll
        for (int db = 0; db < 4; ++db)
#pragma unroll
            for (int g = 0; g < 4; ++g) { u32x2 w; w.x = pk2(o[db][4 * g], o[db][4 * g + 1]); w.y = pk2(o[db][4 * g + 2], o[db][4 * g + 3]); *(u32x2*)(op + 32 * db + 8 * g) = w; }
    }
}

constexpr int GLA_WLS_OFF = 86016;
DI void gla_stage_wlr(const float* wlr, const float* blr, LAS float* WLS, int tid) {
    for (int i = tid; i < 16 * 512 / 4; i += NTHR) ((LAS f32x4*)WLS)[i] = ((const f32x4*)wlr)[i];
    if (tid < 128) ((LAS f32x4*)(WLS + 16 * 512))[tid] = ((const f32x4*)blr)[tid];
}
DI void gla_unit(int un, int& n, int& b, int& h, size_t& tok0) { n = un & 127; const int bh = un >> 7; b = bh >> 2; h = bh & 3; tok0 = (size_t)b * SEQ + n * 64; }
DI void gla_tile_ld(const bf16* Z, size_t tok0, int col, int tid, u32x4 (&r)[2]) {
#pragma unroll
    for (int j = 0; j < 2; ++j) { const int ch = tid + 512 * j, row = ch >> 4, cc = ch & 15; r[j] = *(const u32x4*)(Z + (tok0 + row) * ZC + col + cc * 8); }
}
DI void gla_tile_st(LAS unsigned char* dst, int tid, const u32x4 (&r)[2]) {
#pragma unroll
    for (int j = 0; j < 2; ++j) { const int ch = tid + 512 * j, row = ch >> 4, cc = ch & 15; *(LAS u32x4*)(dst + row * 272 + cc * 16) = r[j]; }
}
DI u32x4 gla_glr_ld(const bf16* Z, size_t tok0, int tid) { const int row = (tid & 127) >> 1, hf = tid & 1; return *(const u32x4*)(Z + (tok0 + row) * ZC + ZLR + hf * 8); }
DI void gla_glr_st(LAS unsigned char* GL, int tid, const u32x4& r) { if (tid < 128) { const int row = tid >> 1, hf = tid & 1; *(LAS u32x4*)(GL + row * 32 + hf * 16) = r; } }
DI void gla_cum(const LAS unsigned char* GL, const LAS float* WLS, int h, LAS float* part, int tid, float (&bc)[16], float& bend) {
    const int k = tid & 127, tg = tid >> 7;
    float wl[16];
#pragma unroll
    for (int r = 0; r < 16; ++r) wl[r] = WLS[r * 512 + h * 128 + k];
    const float bias = WLS[16 * 512 + h * 128 + k];
    float run = 0.f;
#pragma unroll
    for (int i = 0; i < 16; ++i) {
        const LAS u32x4* gp = (const LAS u32x4*)(GL + (tg * 16 + i) * 32); const u32x4 a = gp[0], c = gp[1];
        float pre = bias;
        pre += bflo(a.x) * wl[0] + bfhi(a.x) * wl[1] + bflo(a.y) * wl[2] + bfhi(a.y) * wl[3] + bflo(a.z) * wl[4] + bfhi(a.z) * wl[5] + bflo(a.w) * wl[6] + bfhi(a.w) * wl[7];
        pre += bflo(c.x) * wl[8] + bfhi(c.x) * wl[9] + bflo(c.y) * wl[10] + bfhi(c.y) * wl[11] + bflo(c.z) * wl[12] + bfhi(c.z) * wl[13] + bflo(c.w) * wl[14] + bfhi(c.w) * wl[15];
        run += flogsigmoid(pre) * (1.0f / 16.0f); bc[i] = run;
    }
    part[tg * 128 + k] = run;
    __syncthreads();
    float off = 0.f, tot = 0.f;
#pragma unroll
    for (int g = 0; g < 4; ++g) { const float pv = part[g * 128 + k]; tot += pv; off += (g < tg) ? pv : 0.f; }
#pragma unroll
    for (int i = 0; i < 16; ++i) bc[i] += off;
    bend = tot;
    __syncthreads();
}
#define MFMA16(a, b, c) __builtin_amdgcn_mfma_f32_16x16x32_bf16((a), (b), (c), 0, 0, 0)
DI void phase_gla1(const Frame& F0, const bf16* Z, const bf16* GVT, const float* wlr, const float* blr, bf16* SBUF, float* DBUF) {
    const Frame F = fresh(F0);
    LAS float* part = (LAS float*)F.lds;
    LAS unsigned char* GL = F.lds + 2048;
    LAS unsigned char* KS = F.lds + 4096;
    LAS unsigned char* KT = KS + 17408;
    const int k = F.tid & 127, tg = F.tid >> 7, l15 = F.lane & 15, l4 = F.lane >> 4;
    int un = blockIdx.x; if (un >= 2048) return;
    int n, b, h; size_t tok0; gla_unit(un, n, b, h, tok0);
    LAS float* WLS = (LAS float*)(F.lds + GLA_WLS_OFF); gla_stage_wlr(wlr, blr, WLS, F.tid);
    u32x4 pk_[2], pg_;
    gla_tile_ld(Z, tok0, ZGK + h * 128, F.tid, pk_); pg_ = gla_glr_ld(Z, tok0, F.tid);
    for (;;) {
        gla_tile_st(KS, F.tid, pk_); gla_glr_st(GL, F.tid, pg_);
        bf16x8 bfr[2][2];
#pragma unroll
        for (int ks = 0; ks < 2; ++ks)
#pragma unroll
            for (int nb = 0; nb < 2; ++nb) bfr[ks][nb] = *(const bf16x8*)(GVT + (size_t)(b * 1024 + h * 256 + 32 * F.wave + 16 * nb + l15) * SEQ + n * 64 + 32 * ks + 8 * l4);
        const int un2 = un + F.G; const bool more = un2 < 2048;
        int n2 = 0, b2 = 0, h2 = 0; size_t tok2 = 0;
        if (more) { gla_unit(un2, n2, b2, h2, tok2); gla_tile_ld(Z, tok2, ZGK + h2 * 128, F.tid, pk_); pg_ = gla_glr_ld(Z, tok2, F.tid); }
        __syncthreads();
        float bc[16], bend; gla_cum(GL, WLS, h, part, F.tid, bc, bend);
        unsigned w[8];
#pragma unroll
        for (int i = 0; i < 8; ++i) {
            const float k0 = bf2f(*(const LAS bf16*)(KS + (tg * 16 + 2 * i) * 272 + k * 2)) * fexp2((bend - bc[2 * i]) * LOG2E);
            const float k1 = bf2f(*(const LAS bf16*)(KS + (tg * 16 + 2 * i + 1) * 272 + k * 2)) * fexp2((bend - bc[2 * i + 1]) * LOG2E);
            w[i] = pk2(k0, k1); }
        *(LAS u32x4*)(KT + k * 144 + tg * 32) = (u32x4){w[0], w[1], w[2], w[3]};
        *(LAS u32x4*)(KT + k * 144 + tg * 32 + 16) = (u32x4){w[4], w[5], w[6], w[7]};
        if (tg == 0) DBUF[(size_t)un * 128 + k] = fexp2(bend * LOG2E);
        __syncthreads();
        f32x4 acc[8][2];
#pragma unroll
        for (int mb = 0; mb < 8; ++mb)
#pragma unroll
            for (int nb = 0; nb < 2; ++nb) acc[mb][nb] = (f32x4){0.f, 0.f, 0.f, 0.f};
#pragma unroll
        for (int ks = 0; ks < 2; ++ks) {
#pragma unroll
            for (int mb = 0; mb < 8; ++mb) { const bf16x8 a = *(const LAS bf16x8*)(KT + (16 * mb + l15) * 144 + (32 * ks + 8 * l4) * 2);
#pragma unroll
                for (int nb = 0; nb < 2; ++nb) acc[mb][nb] = MFMA16(a, bfr[ks][nb], acc[mb][nb]); }
        }
#pragma unroll
        for (int mb = 0; mb < 8; ++mb)
#pragma unroll
            for (int nb = 0; nb < 2; ++nb) { const int dv = 32 * F.wave + 16 * nb + l15; u32x2 o; o.x = pk2(acc[mb][nb].x, acc[mb][nb].y); o.y = pk2(acc[mb][nb].z, acc[mb][nb].w);
                *(u32x2*)(SBUF + ((size_t)un * 256 + dv) * 128 + 16 * mb + 4 * l4) = o; }
        __syncthreads();
        if (!more) break;
        un = un2; n = n2; b = b2; h = h2; tok0 = tok2;
    }
}
DI void phase_gla2(const Frame& F0, const bf16* SBUF, const float* DBUF, bf16* DST) {
    const Frame F = fresh(F0);
    for (int e = blockIdx.x * NTHR + F.tid; e < 16 * 256 * 32; e += F.G * NTHR) {
        const int bh = e >> 13, rem = e & 8191, dv = rem >> 5, k4 = (rem & 31) * 4;
        f32x4 s = (f32x4){0.f, 0.f, 0.f, 0.f};
        const float* dp = DBUF + (size_t)bh * 128 * 128 + k4; const size_t off0 = ((size_t)bh * 128 * 256 + dv) * 128 + k4;
        f32x4 d[8]; u32x2 u[8];
#pragma unroll
        for (int j = 0; j < 8; ++j) { d[j] = *(const f32x4*)(dp + (size_t)j * 128); u[j] = *(const u32x2*)(SBUF + off0 + (size_t)j * 256 * 128); }
        for (int n = 0; n < 128; n += 8) {
            f32x4 dn[8]; u32x2 un_[8];
            const int nn = (n + 8 < 128) ? n + 8 : n;
#pragma unroll
            for (int j = 0; j < 8; ++j) { dn[j] = *(const f32x4*)(dp + (size_t)(nn + j) * 128); un_[j] = *(const u32x2*)(SBUF + off0 + (size_t)(nn + j) * 256 * 128); }
#pragma unroll
            for (int j = 0; j < 8; ++j) {
                s.x = d[j].x * s.x + bflo(u[j].x); s.y = d[j].y * s.y + bfhi(u[j].x); s.z = d[j].z * s.z + bflo(u[j].y); s.w = d[j].w * s.w + bfhi(u[j].y);
                u32x2 o; o.x = pk2(s.x, s.y); o.y = pk2(s.z, s.w); *(u32x2*)(DST + off0 + (size_t)(n + j) * 256 * 128) = o;
            }
#pragma unroll
            for (int j = 0; j < 8; ++j) { d[j] = dn[j]; u[j] = un_[j]; }
        }
    }
}
DI void phase_gla3(const Frame& F0, const bf16* Z, const bf16* GVT, const float* wlr, const float* blr, const float* gout, const bf16* SBUF, bf16* outb, int ldo, int ocol, int mode = 0) {
    const Frame F = fresh(F0);
    LAS float* part = (LAS float*)F.lds;
    LAS float* RS = (LAS float*)(F.lds + 2048);
    LAS unsigned char* GL = F.lds + 4096;
    LAS unsigned char* QS = F.lds + 6144;
    LAS unsigned char* KS = QS + 17408;
    LAS unsigned char* SC = KS + 17408;
    LAS unsigned char* OT = SC + 9216;
    const int k = F.tid & 127, tg = F.tid >> 7, l15 = F.lane & 15, l4 = F.lane >> 4, w = F.wave;
    int un = blockIdx.x; if (un >= 2048) return;
    int n, b, h; size_t tok0; gla_unit(un, n, b, h, tok0);
    LAS float* WLS = (LAS float*)(F.lds + GLA_WLS_OFF); gla_stage_wlr(wlr, blr, WLS, F.tid);
    u32x4 pq_[2], pk_[2], pg_;
    gla_tile_ld(Z, tok0, ZGQ + h * 128, F.tid, pq_); gla_tile_ld(Z, tok0, ZGK + h * 128, F.tid, pk_); pg_ = gla_glr_ld(Z, tok0, F.tid);
    for (;;) {
        gla_tile_st(QS, F.tid, pq_); gla_tile_st(KS, F.tid, pk_); gla_glr_st(GL, F.tid, pg_);
        bf16x8 fs[4][2], fv[2][2]; u32x4 grc[4];
#pragma unroll
        for (int ks = 0; ks < 4; ++ks)
#pragma unroll
            for (int mb = 0; mb < 2; ++mb) fs[ks][mb] = *(const bf16x8*)(SBUF + ((size_t)(n > 0 ? un - 1 : un) * 256 + 32 * w + 16 * mb + l15) * 128 + 32 * ks + 8 * l4);
#pragma unroll
        for (int ks = 0; ks < 2; ++ks)
#pragma unroll
            for (int mb = 0; mb < 2; ++mb) fv[ks][mb] = *(const bf16x8*)(GVT + (size_t)(b * 1024 + h * 256 + 32 * w + 16 * mb + l15) * SEQ + n * 64 + 32 * ks + 8 * l4);
#pragma unroll
        for (int j = 0; j < 4; ++j) { const int ch = F.tid + 512 * j; grc[j] = *(const u32x4*)(Z + (tok0 + (ch >> 5)) * ZC + ZGR + h * 256 + (ch & 31) * 8); }
        const int un2 = un + F.G; const bool more = un2 < 2048;
        int n2 = 0, b2 = 0, h2 = 0; size_t tok2 = 0;
        if (more) { gla_unit(un2, n2, b2, h2, tok2); gla_tile_ld(Z, tok2, ZGQ + h2 * 128, F.tid, pq_); gla_tile_ld(Z, tok2, ZGK + h2 * 128, F.tid, pk_); pg_ = gla_glr_ld(Z, tok2, F.tid); }
        __syncthreads();
        float bc[16], bend; gla_cum(GL, WLS, h, part, F.tid, bc, bend);
#pragma unroll
        for (int i = 0; i < 16; ++i) {
            LAS bf16* qp = (LAS bf16*)(QS + (tg * 16 + i) * 272 + k * 2); LAS bf16* kp = (LAS bf16*)(KS + (tg * 16 + i) * 272 + k * 2);
            const float qv = bf2f(*qp) * 0.08838834764831845f * fexp2(bc[i] * LOG2E), kv = bf2f(*kp) * fexp2(-bc[i] * LOG2E);
            *qp = (bf16)(pk2(qv, 0.f) & 0xffffu); *kp = (bf16)(pk2(kv, 0.f) & 0xffffu);
        }
        __syncthreads();
        if (mode == 1) { if (!more) break; un = un2; n = n2; b = b2; h = h2; tok0 = tok2; continue; }
        {
            const int mb = w >> 1;
#pragma unroll
            for (int q = 0; q < 2; ++q) {
                const int nb = 2 * (w & 1) + q;
                f32x4 sc = (f32x4){0.f, 0.f, 0.f, 0.f};
                if (mb <= nb) {
#pragma unroll
                    for (int ks = 0; ks < 4; ++ks) { const bf16x8 a = *(const LAS bf16x8*)(KS + (16 * mb + l15) * 272 + (32 * ks + 8 * l4) * 2), bq = *(const LAS bf16x8*)(QS + (16 * nb + l15) * 272 + (32 * ks + 8 * l4) * 2);
                        sc = MFMA16(a, bq, sc); } }
                const int t = 16 * nb + l15, s_ = 16 * mb + 4 * l4;
                const float v0 = (s_ + 0 <= t) ? sc.x : 0.f, v1 = (s_ + 1 <= t) ? sc.y : 0.f, v2 = (s_ + 2 <= t) ? sc.z : 0.f, v3 = (s_ + 3 <= t) ? sc.w : 0.f;
                u32x2 o; o.x = pk2(v0, v1); o.y = pk2(v2, v3); *(LAS u32x2*)(SC + t * 144 + s_ * 2) = o;
            }
        }
        __syncthreads();
        if (mode == 2) { if (!more) break; un = un2; n = n2; b = b2; h = h2; tok0 = tok2; continue; }
        f32x4 acc[2][4];
#pragma unroll
        for (int mb = 0; mb < 2; ++mb)
#pragma unroll
            for (int nb = 0; nb < 4; ++nb) acc[mb][nb] = (f32x4){0.f, 0.f, 0.f, 0.f};
        if (n > 0) {
#pragma unroll
            for (int ks = 0; ks < 4; ++ks) {
                bf16x8 bq[4];
#pragma unroll
                for (int nb = 0; nb < 4; ++nb) bq[nb] = *(const LAS bf16x8*)(QS + (16 * nb + l15) * 272 + (32 * ks + 8 * l4) * 2);
#pragma unroll
                for (int mb = 0; mb < 2; ++mb)
#pragma unroll
                    for (int nb = 0; nb < 4; ++nb) acc[mb][nb] = MFMA16(fs[ks][mb], bq[nb], acc[mb][nb]);
            }
        }
#pragma unroll
        for (int ks = 0; ks < 2; ++ks) {
            bf16x8 bq[4];
#pragma unroll
            for (int nb = 0; nb < 4; ++nb) bq[nb] = *(const LAS bf16x8*)(SC + (16 * nb + l15) * 144 + (32 * ks + 8 * l4) * 2);
#pragma unroll
            for (int mb = 0; mb < 2; ++mb)
#pragma unroll
                for (int nb = 0; nb < 4; ++nb) acc[mb][nb] = MFMA16(fv[ks][mb], bq[nb], acc[mb][nb]);
        }
        if (mode == 3) { if (acc[0][0].x == 12345.678f) outb[0] = 0; __syncthreads(); if (!more) break; un = un2; n = n2; b = b2; h = h2; tok0 = tok2; continue; }
#pragma unroll
        for (int nb = 0; nb < 4; ++nb) {
            float ss = 0.f;
#pragma unroll
            for (int mb = 0; mb < 2; ++mb) { const f32x4 a = acc[mb][nb]; ss += (a.x * a.x + a.y * a.y) + (a.z * a.z + a.w * a.w);
                u32x2 o; o.x = pk2(a.x, a.y); o.y = pk2(a.z, a.w); *(LAS u32x2*)(OT + (16 * nb + l15) * 528 + (32 * w + 16 * mb + 4 * l4) * 2) = o; }
            ss += __shfl_xor(ss, 16); ss += __shfl_xor(ss, 32);
            if (l4 == 0) RS[w * 64 + 16 * nb + l15] = ss;
        }
        __syncthreads();
#pragma unroll
        for (int j = 0; j < 4; ++j) {
            const int ch = F.tid + 512 * j, t = ch >> 5, dv0 = (ch & 31) * 8;
            float tot = 0.f;
#pragma unroll
            for (int ww = 0; ww < 8; ++ww) tot += RS[ww * 64 + t];
            const float rstd = frsq(tot * (1.0f / 256.0f) + EPS);
            const u32x4 ov = *(const LAS u32x4*)(OT + t * 528 + dv0 * 2), gr = grc[j];
            const f32x4 g0 = *(const f32x4*)(gout + dv0), g1 = *(const f32x4*)(gout + dv0 + 4);
            f32x4 o0, o1, r0, r1; unpack8(ov, o0, o1); unpack8(gr, r0, r1);
            o0 = o0 * rstd * g0 * (f32x4){fsilu(r0.x), fsilu(r0.y), fsilu(r0.z), fsilu(r0.w)}; o1 = o1 * rstd * g1 * (f32x4){fsilu(r1.x), fsilu(r1.y), fsilu(r1.z), fsilu(r1.w)};
            *(u32x4*)(outb + (tok0 + t) * ldo + ocol + h * 256 + dv0) = pack8(o0, o1);
        }
        __syncthreads();
        if (!more) break;
        un = un2; n = n2; b = b2; h = h2; tok0 = tok2;
    }
}

DI void phase_moe_pos(const Frame& F0, const int* sel, const float* selw, const int* cnt, int* slot, float* roww, int* tile_e, int* rowtok) {
    const Frame F = fresh(F0);
    const int c = blockIdx.x, tid = F.tid;
    LAS int* s_sel = (LAS int*)F.lds; LAS int* s_tot = s_sel + 128; LAS int* s_bef = s_tot + 8; LAS int* s_off = s_bef + 8; LAS int* s_base = s_off + 8; LAS int* s_wc = s_base + 8;
    if (tid < 128) s_sel[tid] = sel[c * 128 + tid];
    if (tid < 16) s_tot[tid] = 0;
    __syncthreads();
    {
        const i32x4 v = ((const i32x4*)cnt)[tid]; const bool bf = (tid >> 1) < c;
        int t0 = v.x, t1 = v.y, t2 = v.z, t3 = v.w, b0 = bf ? v.x : 0, b1 = bf ? v.y : 0, b2 = bf ? v.z : 0, b3 = bf ? v.w : 0;
#pragma unroll
        for (int o = 2; o < 64; o <<= 1) { t0 += __shfl_xor(t0, o); t1 += __shfl_xor(t1, o); t2 += __shfl_xor(t2, o); t3 += __shfl_xor(t3, o); b0 += __shfl_xor(b0, o); b1 += __shfl_xor(b1, o); b2 += __shfl_xor(b2, o); b3 += __shfl_xor(b3, o); }
        if (F.lane < 2) { const int e0 = F.lane * 4; atomicAdd((int*)(s_tot + e0), t0); atomicAdd((int*)(s_tot + e0 + 1), t1); atomicAdd((int*)(s_tot + e0 + 2), t2); atomicAdd((int*)(s_tot + e0 + 3), t3);
            atomicAdd((int*)(s_bef + e0), b0); atomicAdd((int*)(s_bef + e0 + 1), b1); atomicAdd((int*)(s_bef + e0 + 2), b2); atomicAdd((int*)(s_bef + e0 + 3), b3); }
    }
    int e_i = 0, rank = 0;
    if (tid < 256) {
        const int sv = s_sel[tid >> 1]; e_i = (tid & 1) ? (sv >> 8) : (sv & 255);
#pragma unroll
        for (int e = 0; e < NE; ++e) { const unsigned long long m = __ballot(e_i == e); if (e_i == e) rank = __popcll(m & ((1ull << F.lane) - 1ull)); if (F.lane == 0) s_wc[F.wave * 8 + e] = __popcll(m); }
    }
    __syncthreads();
    if (tid == 0) {
        int base = 0;
        for (int e = 0; e < NE; ++e) { s_base[e] = base; s_off[e] = base + s_bef[e]; const int nt = (s_tot[e] + 255) >> 8; if (c == 0) for (int t = 0; t < nt; ++t) tile_e[1 + (base >> 8) + t] = e; base += nt * 256; }
        if (c == 0) tile_e[0] = base >> 8;
    }
    __syncthreads();
    if (tid < 256) {
        int pre = 0; for (int w = 0; w < F.wave; ++w) pre += s_wc[w * 8 + e_i];
        const int pos = s_off[e_i] + pre + rank, tok = c * 128 + (tid >> 1);
        slot[2 * tok + (tid & 1)] = pos; roww[pos] = selw[2 * tok + (tid & 1)]; rowtok[pos] = tok;
    }
    if (c == 0) for (int e = 0; e < NE; ++e) { const int tot = s_tot[e], pad = ((tot + 255) >> 8) << 8; for (int r = tot + tid; r < pad; r += NTHR) rowtok[s_base[e] + r] = 0; }
}
DI void phase_moe_combine(const Frame& F0, const int* slot, const bf16* YSORT, bf16* X, bf16* HB) {
    const Frame F = fresh(F0);
    for (int m = F.gw; m < T; m += F.ngw) {
        const int p0 = slot[2 * m], p1 = slot[2 * m + 1];
#pragma unroll
        for (int j = 0; j < 8; ++j) { const int idx = F.lane + 64 * j; const u32x2 xw = ((const u32x2*)(X + (size_t)m * D))[idx]; f32x4 x = (f32x4){bflo(xw.x), bfhi(xw.x), bflo(xw.y), bfhi(xw.y)};
            const int y0 = ((const int*)((const unsigned char*)YSORT + (size_t)p0 * D))[idx], y1 = ((const int*)((const unsigned char*)YSORT + (size_t)p1 * D))[idx];
            const f32x2 a0 = __builtin_amdgcn_cvt_pk_f32_fp8(y0, false), a1 = __builtin_amdgcn_cvt_pk_f32_fp8(y0, true), b0 = __builtin_amdgcn_cvt_pk_f32_fp8(y1, false), b1 = __builtin_amdgcn_cvt_pk_f32_fp8(y1, true);
            x.x += (a0.x + b0.x) * 0.0625f; x.y += (a0.y + b0.y) * 0.0625f; x.z += (a1.x + b1.x) * 0.0625f; x.w += (a1.y + b1.y) * 0.0625f;
            u32x2 ow; ow.x = pk2(x.x, x.y); ow.y = pk2(x.z, x.w); ((u32x2*)(X + (size_t)m * D))[idx] = ow; ((unsigned*)((unsigned char*)HB + (size_t)m * D))[idx] = pk4_fp8(x.x, x.y, x.z, x.w); }
    }
}

using pg8::Unit;
typedef f32x4 AccT[2][2][4][2];
constexpr float GATE_TINY = 8.673617379884035e-19f;
struct PBase { pg8::StaticOrder so; int K, lda, ldb; };
DI unsigned pk4_u8(const f32x4& g) { const float a = fmaxf(__builtin_floorf(g.x * 255.0f + 0.5f), 1.0f), b = fmaxf(__builtin_floorf(g.y * 255.0f + 0.5f), 1.0f), c = fmaxf(__builtin_floorf(g.z * 255.0f + 0.5f), 1.0f), d = fmaxf(__builtin_floorf(g.w * 255.0f + 0.5f), 1.0f);
    unsigned w = 0; w = __builtin_amdgcn_cvt_pk_u8_f32(a, 0, w); w = __builtin_amdgcn_cvt_pk_u8_f32(b, 1, w); w = __builtin_amdgcn_cvt_pk_u8_f32(c, 2, w); w = __builtin_amdgcn_cvt_pk_u8_f32(d, 3, w); return w; }
DI f32x4 u8x4_f(unsigned w) { return (f32x4){(float)(w & 0xffu), (float)((w >> 8) & 0xffu), (float)((w >> 16) & 0xffu), (float)(w >> 24)}; }
DI f32x4 exp2_4(const f32x4& v) { return (f32x4){fexp2(v.x), fexp2(v.y), fexp2(v.z), fexp2(v.w)}; }
DI f32x4 max4(const f32x4& v, float m) { return (f32x4){fmaxf(v.x, m), fmaxf(v.y, m), fmaxf(v.z, m), fmaxf(v.w, m)}; }
DI f32x4 rcp4(const f32x4& v) { return (f32x4){frcp(v.x), frcp(v.y), frcp(v.z), frcp(v.w)}; }
DI f32x4 sig4(const f32x4& v) { return rcp4(exp2_4(v * (-LOG2E)) + 1.0f); }
DI f32x4 swi4(const f32x4& a, const f32x4& b) { return a * sig4(a) * b; }

DI void touch_lines(const char* base, size_t pitch_bytes, int lpr_shift, int nlines, int wid, int lane, LAS unsigned char* lds) {
    for (int i = wid * 64 + lane; i < nlines; i += 512) { const int row = i >> lpr_shift, seg = i & ((1 << lpr_shift) - 1);
        __builtin_amdgcn_global_load_lds((const unsigned*)(base + (size_t)row * pitch_bytes + seg * 128), (LAS unsigned*)(lds + JUNK_OFF + wid * 256), 4, 0, 0); }
}
DI float rstd_of(const unsigned long long* ssq, int row) { return ssq ? frsq((float)ssq[row] * (SSQ_UNFIX / D) + EPS) : 1.0f; }
struct PIn : PBase {
    static constexpr bool PERM = true, FP8 = false, PREFETCH = false, SWAPMM = false, GATHER = false; static constexpr int BSCALE = 0x7f7f7f7f;
    const bf16* A; const bf16* Bt; bf16* Zo; const unsigned long long* ssq;
    DI static int ztile(int pn) { return pn < 12 ? pn : (pn < 16 ? pn + 4 : pn + 8); }
    DI bool next(int i, Unit& u) const { u.aux = 0; return so.tile(i, u.pm, u.pn); }
    DI const char* a_base(const Unit& u) const { return (const char*)(A + (size_t)u.pm * 256 * lda); }
    DI const char* b_base(const Unit& u) const { return (const char*)(Bt + (size_t)ztile(u.pn) * 256 * ldb); }
    DI bool epi(AccT& acc, const Unit& u, int wr, int wc, int fr, int fq) const {
        const int row0 = u.pm * 256 + wr * 64 + fr, col0 = ztile(u.pn) * 256 + wc * 32 + 8 * fq;
        float rs[2][4];
#pragma unroll
        for (int ai = 0; ai < 2; ++ai)
#pragma unroll
            for (int m = 0; m < 4; ++m) rs[ai][m] = rstd_of(ssq, row0 + ai * 128 + m * 16);
#pragma unroll
        for (int ai = 0; ai < 2; ++ai)
#pragma unroll
            for (int m = 0; m < 4; ++m) { bf16* rowp = Zo + (size_t)(row0 + ai * 128 + m * 16) * ZC + col0;
#pragma unroll
                for (int bj = 0; bj < 2; ++bj) *(u32x4*)(rowp + bj * 128) = pack8(acc[ai][bj][m][0] * rs[ai][m], acc[ai][bj][m][1] * rs[ai][m]);
                asm volatile("" ::: "memory"); }
        return true;
    }
};
struct PInVT : PBase {
    static constexpr bool PERM = false, FP8 = false, PREFETCH = false, SWAPMM = true, GATHER = false; static constexpr int BSCALE = 0x7f7f7f7f;
    const bf16* A; const bf16* Bt; bf16* SVTo; bf16* GVTo; const unsigned long long* ssq;
    DI bool next(int i, Unit& u) const { u.aux = 0; return so.tile(i, u.pm, u.pn); }
    DI const char* a_base(const Unit& u) const { return (const char*)(A + (size_t)u.pm * 256 * lda); }
    DI const char* b_base(const Unit& u) const { return (const char*)(Bt + (size_t)(u.pn < 4 ? 12 + u.pn : 16 + u.pn) * 256 * ldb); }
    DI bool epi(AccT& acc, const Unit& u, int wr, int wc, int fr, int fq) const {
        bf16* dst = u.pn < 4 ? SVTo : GVTo;
        const int b = (u.pm * 256) / SEQ, s0 = (u.pm * 256) % SEQ + wr * 64 + 4 * fq, ch0 = (u.pn & 3) * 256 + wc * 32 + fr;
        f32x4 rs[2][4];
#pragma unroll
        for (int ai = 0; ai < 2; ++ai)
#pragma unroll
            for (int m = 0; m < 4; ++m) { const int t0 = u.pm * 256 + wr * 64 + 4 * fq + ai * 128 + m * 16;
                rs[ai][m] = (f32x4){rstd_of(ssq, t0), rstd_of(ssq, t0 + 1), rstd_of(ssq, t0 + 2), rstd_of(ssq, t0 + 3)}; }
#pragma unroll
        for (int bj = 0; bj < 2; ++bj)
#pragma unroll
            for (int n = 0; n < 2; ++n) { bf16* rowp = dst + ((size_t)(b * 1024 + ch0 + bj * 128 + n * 16)) * SEQ + s0;
#pragma unroll
                for (int ai = 0; ai < 2; ++ai)
#pragma unroll
                    for (int m = 0; m < 4; ++m) { const f32x4 a = acc[ai][bj][m][n] * rs[ai][m]; u32x2 o; o.x = pk2(a.x, a.y); o.y = pk2(a.z, a.w); *(u32x2*)(rowp + ai * 128 + m * 16) = o; }
                asm volatile("" ::: "memory"); }
        return true;
    }
};
struct PGates : PBase {
    static constexpr bool PERM = true, FP8 = true, PREFETCH = false, SWAPMM = false, GATHER = false; static constexpr int BSCALE = 0x79797979;
    const bf16* A; const bf16* Bt; bf16* Go; const float* bias; const unsigned long long* ssq;
    DI bool next(int i, Unit& u) const { u.aux = 0; return so.tile(i, u.pm, u.pn); }
    DI const char* a_base(const Unit& u) const { return (const char*)(A + (size_t)u.pm * 256 * lda); }
    DI const char* b_base(const Unit& u) const { return (const char*)(Bt + (size_t)u.pn * 256 * ldb); }
    DI bool epi(AccT& acc, const Unit& u, int wr, int wc, int fr, int fq) const {
        const int row0 = u.pm * 256 + wr * 64 + fr, col0 = u.pn * 256 + wc * 32 + 8 * fq;
        f32x4 bv[2][2];
#pragma unroll
        for (int bj = 0; bj < 2; ++bj)
#pragma unroll
            for (int n = 0; n < 2; ++n) bv[bj][n] = *(const f32x4*)(bias + col0 + bj * 128 + 4 * n);
        float rs[2][4];
#pragma unroll
        for (int ai = 0; ai < 2; ++ai)
#pragma unroll
            for (int m = 0; m < 4; ++m) rs[ai][m] = rstd_of(ssq, row0 + ai * 128 + m * 16);
#pragma unroll
        for (int ai = 0; ai < 2; ++ai)
#pragma unroll
            for (int m = 0; m < 4; ++m) { unsigned char* rowp = (unsigned char*)Go + (size_t)(row0 + ai * 128 + m * 16) * GC + col0;
#pragma unroll
                for (int bj = 0; bj < 2; ++bj) { u32x2 o; o.x = pk4_u8(sig4(acc[ai][bj][m][0] * rs[ai][m] + bv[bj][0])); o.y = pk4_u8(sig4(acc[ai][bj][m][1] * rs[ai][m] + bv[bj][1])); *(u32x2*)(rowp + bj * 128) = o; }
                asm volatile("" ::: "memory"); }
        return true;
    }
};
struct PPool : PBase {
    static constexpr bool PERM = true, FP8 = false, PREFETCH = false, SWAPMM = false, GATHER = false; static constexpr int BSCALE = 0x7f7f7f7f;
    const bf16* A; const bf16* Bt; bf16* Zo; const float* scale;
    DI bool next(int i, Unit& u) const { u.aux = 0; return so.tile(i, u.pm, u.pn); }
    DI const char* a_base(const Unit& u) const { return (const char*)(A + (size_t)u.pm * 256 * 1024 + u.pn * 256); }
    DI const char* b_base(const Unit& u) const { return (const char*)(Bt + (size_t)u.pn * 256 * 256); }
    DI bool epi(AccT& acc, const Unit& u, int wr, int wc, int fr, int fq) const {
        const int row0 = u.pm * 256 + wr * 64 + fr, col0 = u.pn * 256 + wc * 32 + 8 * fq;
        f32x4 sv[2][2];
#pragma unroll
        for (int bj = 0; bj < 2; ++bj)
#pragma unroll
            for (int n = 0; n < 2; ++n) sv[bj][n] = *(const f32x4*)(scale + col0 + bj * 128 + 4 * n);
#pragma unroll
        for (int ai = 0; ai < 2; ++ai)
#pragma unroll
            for (int m = 0; m < 4; ++m) { bf16* rowp = Zo + (size_t)(row0 + ai * 128 + m * 16) * ZC + ZU + col0;
#pragma unroll
                for (int bj = 0; bj < 2; ++bj) *(u32x4*)(rowp + bj * 128) = pack8(acc[ai][bj][m][0] * sv[bj][0], acc[ai][bj][m][1] * sv[bj][1]);
                asm volatile("" ::: "memory"); }
        return true;
    }
};
struct PUp : PBase {
    static constexpr bool PERM = true, FP8 = false, PREFETCH = false, SWAPMM = false, GATHER = false; static constexpr int BSCALE = 0x7f7f7f7f;
    const bf16* Zi; const bf16* Wup; const bf16* Gi; bf16* Mo;
    DI bool next(int i, Unit& u) const { u.aux = i % 3; return so.tile(i / 3, u.pm, u.pn); }
    DI const char* a_base(const Unit& u) const { return (const char*)(Zi + (size_t)u.pm * 256 * ZC + (u.aux == 0 ? ZU : (u.aux == 1 ? ZSQ : ZGR))); }
    DI const char* b_base(const Unit& u) const { return (const char*)(Wup + (size_t)u.aux * 2048 * 1024 + (size_t)u.pn * 256 * 1024); }
    DI void pre_epi(const Unit& u, int wid, int lane, LAS unsigned char* lds) const {
        touch_lines((const char*)(Gi + (size_t)u.pm * 256 * GC + u.aux * 2048 + u.pn * 256), (size_t)GC * 2, 2, 1024, wid, lane, lds);
        if (u.aux < 2) touch_lines((const char*)(Gi + (size_t)u.pm * 256 * GC + (u.aux + 1) * 2048 + u.pn * 256), (size_t)GC * 2, 2, 1024, wid, lane, lds);
    }
    DI bool epi(AccT& acc, const Unit& u, int wr, int wc, int fr, int fq) const {
        const int row0 = u.pm * 256 + wr * 64 + fr, col0 = u.pn * 256 + wc * 32 + 8 * fq;
        const bool lastb = (u.aux == 2);
        const unsigned char* gbase = (const unsigned char*)Gi + (size_t)row0 * GC + u.aux * 2048 + col0; const int noff = lastb ? 0 : 2048;
        u32x2 cur[4], nxt[4], nx2[4];
#define PUP_LOAD(dst, g) do { const unsigned char* gp_ = gbase + (size_t)(((g) >> 2) * 128 + ((g) & 3) * 16) * GC; \
            dst[0] = *(const u32x2*)(gp_); dst[1] = *(const u32x2*)(gp_ + 128); dst[2] = *(const u32x2*)(gp_ + noff); dst[3] = *(const u32x2*)(gp_ + noff + 128); } while (0)
        PUP_LOAD(cur, 0); PUP_LOAD(nxt, 1);
#pragma unroll
        for (int g = 0; g < 8; ++g) {
            const int ai = g >> 2, m = g & 3;
            if (g < 6) PUP_LOAD(nx2, g + 2);
            bf16* op = Mo + (size_t)(row0 + ai * 128 + m * 16) * D + col0;
#pragma unroll
            for (int bj = 0; bj < 2; ++bj) { const f32x4 c0 = u8x4_f(cur[bj].x), c1 = u8x4_f(cur[bj].y), n0 = u8x4_f(cur[2 + bj].x), n1 = u8x4_f(cur[2 + bj].y);
                f32x4 r0 = rcp4(n0), r1 = rcp4(n1);
                if (lastb) { r0 = (f32x4){1.f / 255.f, 1.f / 255.f, 1.f / 255.f, 1.f / 255.f}; r1 = r0; }
                acc[ai][bj][m][0] = acc[ai][bj][m][0] * (c0 * r0); acc[ai][bj][m][1] = acc[ai][bj][m][1] * (c1 * r1);
                if (lastb) *(u32x4*)(op + bj * 128) = pack8(acc[ai][bj][m][0], acc[ai][bj][m][1]); }
#pragma unroll
            for (int q = 0; q < 4; ++q) { cur[q] = nxt[q]; nxt[q] = nx2[q]; }
        }
#undef PUP_LOAD
        return lastb;
    }
};
template <int MODE, bool FP8_ = false> struct PResid : PBase {
    static constexpr bool PERM = false, FP8 = FP8_, PREFETCH = false, SWAPMM = false, GATHER = false; static constexpr int BSCALE = FP8_ ? 0x79797979 : 0x7f7f7f7f;
    const bf16* A; const bf16* Bt; bf16* X; bf16* XB; const bf16* PPi; float* OUT; bool fin; unsigned long long* ssq; unsigned char* X8;
    DI bool next(int i, Unit& u) const { u.aux = 0; return so.tile(i, u.pm, u.pn); }
    DI const char* a_base(const Unit& u) const { return (const char*)(A + (size_t)u.pm * 256 * lda); }
    DI const char* b_base(const Unit& u) const { return (const char*)(Bt + (size_t)u.pn * 256 * ldb); }
    DI void pre_epi(const Unit& u, int wid, int lane, LAS unsigned char* lds) const {
        touch_lines((const char*)(X + (size_t)u.pm * 256 * D + u.pn * 256), (size_t)D * 2, 2, 1024, wid, lane, lds);
        if (MODE == 2) touch_lines((const char*)(PPi + (size_t)u.pm * 256 * D + u.pn * 256), (size_t)D * 2, 2, 1024, wid, lane, lds);
    }
    DI bool epi(AccT& acc, const Unit& u, int wr, int wc, int fr, int fq) const {
        const int row0 = u.pm * 256 + wr * 64 + fr, col0 = u.pn * 256 + wc * 32 + 4 * fq;
        u32x2 cx[2][2], nx[2][2], cp[2][2], np_[2][2];
#define PR_LOAD(dx, dp, g) do { const size_t off_ = (size_t)(row0 + ((g) >> 2) * 128 + ((g) & 3) * 16) * D + col0; \
            _Pragma("unroll") for (int bj = 0; bj < 2; ++bj) _Pragma("unroll") for (int n = 0; n < 2; ++n) { dx[bj][n] = *(const u32x2*)(X + off_ + bj * 128 + n * 16); if (MODE == 2) dp[bj][n] = *(const u32x2*)(PPi + off_ + bj * 128 + n * 16); } } while (0)
        PR_LOAD(cx, cp, 0);
#pragma unroll
        for (int g = 0; g < 8; ++g) {
            const int ai = g >> 2, m = g & 3; const size_t off = (size_t)(row0 + ai * 128 + m * 16) * D + col0;
            if (g < 7) PR_LOAD(nx, np_, g + 1);
            float gss = 0.f;
#pragma unroll
            for (int bj = 0; bj < 2; ++bj)
#pragma unroll
                for (int n = 0; n < 2; ++n) { f32x4 a = acc[ai][bj][m][n];
                    if (MODE == 2) { const u32x2 w = cp[bj][n]; a = sig4(a) * (f32x4){bflo(w.x), bfhi(w.x), bflo(w.y), bfhi(w.y)}; }
                    const u32x2 xw = cx[bj][n]; const f32x4 x = (f32x4){bflo(xw.x), bfhi(xw.x), bflo(xw.y), bfhi(xw.y)} + a;
                    if (fin) *(f32x4*)(OUT + off + bj * 128 + n * 16) = x; else { u32x2 ow; ow.x = pk2(x.x, x.y); ow.y = pk2(x.z, x.w); *(u32x2*)(X + off + bj * 128 + n * 16) = ow;
                        if (ssq) { const float r0 = bflo(ow.x), r1 = bfhi(ow.x), r2 = bflo(ow.y), r3 = bfhi(ow.y); gss += (r0 * r0 + r1 * r1) + (r2 * r2 + r3 * r3); }
                        if (X8) *(unsigned*)(X8 + off + bj * 128 + n * 16) = pk4_fp8(x.x, x.y, x.z, x.w); }
                    if (MODE == 1) *(unsigned*)((unsigned char*)XB + off + bj * 128 + n * 16) = pk4_fp8(x.x, x.y, x.z, x.w); }
            if (ssq) {
                gss += __shfl_xor(gss, 16); gss += __shfl_xor(gss, 32);
                if (fq == 0) (void)__hip_atomic_fetch_add(ssq + row0 + ai * 128 + m * 16, (unsigned long long)(gss * SSQ_FIX + 0.5f), __ATOMIC_RELAXED, __HIP_MEMORY_SCOPE_AGENT); }
#pragma unroll
            for (int bj = 0; bj < 2; ++bj)
#pragma unroll
                for (int n = 0; n < 2; ++n) { cx[bj][n] = nx[bj][n]; if (MODE == 2) cp[bj][n] = np_[bj][n]; }
        }
#undef PR_LOAD
        return true;
    }
};
template <bool GROUPED, bool F8 = true, bool OUT8 = F8> struct PSwiglu : PBase {
    static constexpr bool PERM = true, FP8 = F8, PREFETCH = false, SWAPMM = false, GATHER = GROUPED; static constexpr int BSCALE = F8 ? 0x79797979 : 0x7f7f7f7f;
    const unsigned char* A; const unsigned char* Bt; unsigned char* O; const int* tile_e; const int* rowtok; const unsigned long long* ssq;
    DI bool next(int i, Unit& u) const { const bool ok = so.tile(i, u.pm, u.pn); u.aux = (GROUPED && ok) ? tile_e[1 + u.pm] : 0; return ok; }
    DI const char* a_base(const Unit& u) const { return GROUPED ? (const char*)A : (const char*)(A + (size_t)u.pm * 256 * lda * 2); }
    DI unsigned row_off(const Unit& u, int r) const { return (unsigned)rowtok[u.pm * 256 + r] * (unsigned)(lda * 2); }
    DI const char* b_base(const Unit& u) const { return (const char*)(Bt + (size_t)u.aux * WMOE_E + (size_t)u.pn * 256 * ldb * 2); }
    DI bool epi(AccT& acc, const Unit& u, int wr, int wc, int fr, int fq) const {
        const int row0 = u.pm * 256 + wr * 64 + fr, col0 = u.pn * 128 + wc * 32 + 8 * fq;
#pragma unroll
        for (int ai = 0; ai < 2; ++ai)
#pragma unroll
            for (int m = 0; m < 4; ++m) { const float rs = GROUPED ? 1.0f : rstd_of(ssq, row0 + ai * 128 + m * 16);
                const f32x4 v0 = swi4(acc[ai][0][m][0] * rs, acc[ai][1][m][0] * rs), v1 = swi4(acc[ai][0][m][1] * rs, acc[ai][1][m][1] * rs);
                if constexpr (OUT8) { u32x2 o; o.x = pk4_fp8(v0.x, v0.y, v0.z, v0.w); o.y = pk4_fp8(v1.x, v1.y, v1.z, v1.w); *(u32x2*)(O + (size_t)(row0 + ai * 128 + m * 16) * DFF + col0) = o; }
                else *(u32x4*)((bf16*)O + (size_t)(row0 + ai * 128 + m * 16) * DFF + col0) = pack8(v0, v1);
                asm volatile("" ::: "memory"); }
        return true;
    }
};
template <bool GROUPED, bool FP8_ = false> struct PBf16 : PBase {
    static constexpr bool PERM = true, FP8 = FP8_, PREFETCH = false, SWAPMM = false, GATHER = false; static constexpr int BSCALE = FP8_ ? 0x79797979 : 0x7f7f7f7f;
    const bf16* A; const unsigned char* Bt; bf16* O; int ldo; const int* tile_e; const float* rw;
    DI bool next(int i, Unit& u) const { const bool ok = so.tile(i, u.pm, u.pn); u.aux = (GROUPED && ok) ? tile_e[1 + u.pm] : 0; return ok; }
    DI const char* a_base(const Unit& u) const { return (const char*)(A + (size_t)u.pm * 256 * lda); }
    DI const char* b_base(const Unit& u) const { return (const char*)(Bt + (size_t)u.aux * WMOE_E + (size_t)u.pn * 256 * ldb * 2); }
    DI bool epi(AccT& acc, const Unit& u, int wr, int wc, int fr, int fq) const {
        const int row0 = u.pm * 256 + wr * 64 + fr, col0 = u.pn * 256 + wc * 32 + 8 * fq;
        float sw[2][4];
#pragma unroll
        for (int ai = 0; ai < 2; ++ai)
#pragma unroll
            for (int m = 0; m < 4; ++m) sw[ai][m] = GROUPED ? rw[row0 + ai * 128 + m * 16] : 1.0f;
#pragma unroll
        for (int ai = 0; ai < 2; ++ai)
#pragma unroll
            for (int m = 0; m < 4; ++m) { const int r = row0 + ai * 128 + m * 16; const float s = sw[ai][m]; bf16* rowp = O + (size_t)r * ldo + col0;
#pragma unroll
                for (int bj = 0; bj < 2; ++bj) {
                    if constexpr (GROUPED) { const f32x4 a = acc[ai][bj][m][0] * (16.0f * s), b = acc[ai][bj][m][1] * (16.0f * s);
                        u32x2 o; o.x = pk4_fp8(a.x, a.y, a.z, a.w); o.y = pk4_fp8(b.x, b.y, b.z, b.w); *(u32x2*)((unsigned char*)O + (size_t)r * ldo + col0 + bj * 128) = o; }
                    else *(u32x4*)(rowp + bj * 128) = pack8(acc[ai][bj][m][0] * s, acc[ai][bj][m][1] * s); }
                asm volatile("" ::: "memory"); }
        return true;
    }
};

constexpr int PH_PER_LAYER = 18, NPH = 1 + 2 * PH_PER_LAYER;
typedef const Args __attribute__((address_space(4)))* ArgP;
DI ArgP argp() { unsigned long long p = (unsigned long long)__builtin_amdgcn_kernarg_segment_ptr(); asm volatile("" : "+s"(p)); return (ArgP)p; }
#define AIN(k) (argp()->in[k])
__global__ void __launch_bounds__(NTHR, 2) fwd(Args args_unused) {
    extern __shared__ __attribute__((aligned(16))) unsigned char lds_raw[];
    Frame F;
    F.lds = (LAS unsigned char*)lds_raw;
    F.tid = threadIdx.x; F.lane = F.tid & 63; F.wave = __builtin_amdgcn_readfirstlane(F.tid >> 6);
    F.G = gridDim.x; { const int bx = blockIdx.x; F.vcu = (F.G % 8 == 0) ? (bx % 8) * (F.G / 8) + bx / 8 : bx; }
    F.gw = F.vcu * NWAVES + F.wave; F.ngw = F.G * NWAVES;
    volatile LAS unsigned* MISC = (volatile LAS unsigned*)(F.lds + MISC_OFF);
    if (F.tid < 16) MISC[F.tid] = 0u;
    __syncthreads();
    unsigned char* ws = argp()->ws;
    unsigned* ctl = (unsigned*)(ws + WS_CTL);
    const int lo = argp()->ph_lo, hi = argp()->ph_hi;
    XcdBarrier bar; bar.bar = ctl + CW_BAR; bar.x = 0; bar.st = MISC + 8;
    if (hi - lo > 1) bar = xcd_barrier_post(ctl + CW_BAR, MISC + 8);
#ifndef ONLY_SITE
#define ONLY_SITE -1
#endif
#ifndef ONLY_SUB
#define ONLY_SUB -1
#endif
#define SITE_ON(k) (ONLY_SITE < 0 || ONLY_SITE == (k))
#define SUB_ON(k) (ONLY_SUB < 0 || ONLY_SUB == (k))
#define IN(k) (lo <= (k) && (k) < hi)
#define SEAM(k) do { if ((k) + 1 < hi || DBG_TIME_MASK != 0ull || FP8_SELFTEST) xcd_barrier(bar); if (DBG_TIME_MASK != 0ull && blockIdx.x == 0 && threadIdx.x == 0) ((unsigned long long*)(ctl + 32768))[(k) + 1] = __builtin_amdgcn_s_memrealtime(); } while (0)
    bf16* X = (bf16*)(ws + WS_END);
    float* OUTF = argp()->out;

#if FP8_SELFTEST
    if (lo == 0 && blockIdx.x == 0 && F.wave == 0) {
        typedef int i32x8 __attribute__((ext_vector_type(8)));
        const int l = F.lane, i = l & 15, g = l >> 4;
        i32x8 a, b;
#pragma unroll
        for (int d = 0; d < 8; ++d) {
            float av[4], bv[4];
#pragma unroll
            for (int q = 0; q < 4; ++q) { const int k = 32 * g + 4 * d + q; av[q] = (float)(((i * 7 + k * 3) % 5) - 2); bv[q] = (float)(((k * 5 + i * 11) % 7) - 3); }
            int wa = 0, wb = 0;
            wa = __builtin_amdgcn_cvt_pk_fp8_f32(av[0], av[1], wa, false); wa = __builtin_amdgcn_cvt_pk_fp8_f32(av[2], av[3], wa, true);
            wb = __builtin_amdgcn_cvt_pk_fp8_f32(bv[0], bv[1], wb, false); wb = __builtin_amdgcn_cvt_pk_fp8_f32(bv[2], bv[3], wb, true);
            a[d] = wa; b[d] = wb;
        }
        f32x4 c1 = (f32x4){0.f, 0.f, 0.f, 0.f}, c2 = c1;
        c1 = __builtin_amdgcn_mfma_scale_f32_16x16x128_f8f6f4(a, b, c1, 0, 0, 0, 0x7f7f7f7f, 0, 0x7f7f7f7f);
        c2 = __builtin_amdgcn_mfma_scale_f32_16x16x128_f8f6f4(a, b, c2, 0, 0, 0, 0x7f7f7f7f, 0, 0x79797979);
        bool ok = true;
#pragma unroll
        for (int q = 0; q < 4; ++q) { const int r = 4 * g + q; float ref = 0.f;
            for (int k = 0; k < 128; ++k) ref += (float)(((r * 7 + k * 3) % 5) - 2) * (float)(((k * 5 + i * 11) % 7) - 3);
            ok = ok && fabsf(c1[q] - ref) < 0.25f && fabsf(c2[q] * 64.0f - ref) < 0.25f; }
        const bool all_ok = __all(ok);
        if (l == 0) ctl[40000] = all_ok ? 1u : 2u;
    }
#endif
    if (DBG_TIME_MASK != 0ull && blockIdx.x == 0 && threadIdx.x == 0) ((unsigned long long*)(ctl + 32768))[0] = __builtin_amdgcn_s_memrealtime();
    bf16* HB = (bf16*)(ws + WS_HB); bf16* PP = (bf16*)(ws + WS_PP); bf16* Z = (bf16*)(ws + WS_Z); bf16* GATES = (bf16*)(ws + WS_GATES);
    bf16* POOLED = (bf16*)(ws + WS_POOLED); bf16* SVT = (bf16*)(ws + WS_SVT); bf16* GVT = (bf16*)(ws + WS_GVT); bf16* SBUF = (bf16*)(ws + WS_SBUF);
    float* DBUF = (float*)(ws + WS_DBUF);
    int* SEL = (int*)(ws + WS_MISC + MISC_SEL); float* SELW = (float*)(ws + WS_MISC + MISC_SELW); int* SLOT = (int*)(ws + WS_MISC + MISC_SLOT); int* CNT = (int*)(ws + WS_MISC + MISC_CNT);
    float* ROWW = (float*)(ws + WS_MISC + MISC_ROWW); int* TILE_E = (int*)(ws + WS_MISC + MISC_TILE);
    const int c = (int)blockIdx.x;

    if (SITE_ON(100) && IN(0)) {
        for (int rep = 0; rep < ((DUP_MASK & 2) ? 2 : 1); ++rep) {
        int rot = 0;
        for (int L = 0; L < 2; ++L) {
            unsigned char* wl = ws + WS_W + (size_t)L * WL_SIZE;
            const float* gfold = (L == 1) ? AIN(I_GMIX) + D : nullptr;
            convert_matrix(F, AIN(I_WIN) + (size_t)L * D * IN_COLS, D, IN_COLS, (bf16*)(wl + WL_WIN), 1, 0, rot, -1, gfold); rot += 32 * 225;
            convert_matrix<true>(F, AIN(I_WBG) + (size_t)L * D * GC, D, GC, (bf16*)(wl + WL_WBG8), 0, 0, rot, -1, gfold); rot += 32 * 192;
            for (int g = 0; g < 4; ++g) { convert_matrix(F, AIN(I_POOLW) + (size_t)(L * 4 + g) * 65536, 256, 256, (bf16*)(wl + WL_POOL) + g * 65536, 0, 0, rot); rot += 32; }
            convert_matrix(F, AIN(I_WUPP) + (size_t)L * 1024 * D, 1024, D, (bf16*)(wl + WL_WUP), 0, 0, rot); rot += 16 * 64;
            convert_matrix(F, AIN(I_WUPS) + (size_t)L * 1024 * D, 1024, D, (bf16*)(wl + WL_WUP) + (size_t)1 * D * 1024, 0, 0, rot); rot += 16 * 64;
            convert_matrix(F, AIN(I_WUPG) + (size_t)L * 1024 * D, 1024, D, (bf16*)(wl + WL_WUP) + (size_t)2 * D * 1024, 0, 0, rot); rot += 16 * 64;
            convert_matrix(F, AIN(I_WO) + (size_t)L * D * D, D, D, (bf16*)(wl + WL_WO), 0, 0, rot); rot += 32 * 64;
            convert_matrix(F, AIN(I_PLEP) + (size_t)L * PLE * D, PLE, D, (bf16*)(wl + WL_PLEP), 0, 0, rot); rot += 4 * 64;
            convert_matrix<true>(F, AIN(I_PLEG) + (size_t)L * D * D, D, D, (bf16*)(wl + WL_PLEG), 0, 0, rot); rot += 32 * 64;
        }
        convert_matrix<DENSE_FP8 != 0>(F, AIN(I_FW1), D, DFF, (bf16*)(ws + WS_FFN13), 2, 0, rot, -1, AIN(I_GFFN)); rot += 32 * 176;
        convert_matrix<DENSE_FP8 != 0>(F, AIN(I_FW3), D, DFF, (bf16*)(ws + WS_FFN13), 3, 0, rot, -1, AIN(I_GFFN)); rot += 32 * 176;
        convert_matrix<(DENSE_FP8 != 0) || (DENSE2_FP8 != 0)>(F, AIN(I_FW2), DFF, D, (bf16*)(ws + WS_FFN2), 0, 0, rot);
        }
        {
            const f32x4* src = (const f32x4*)AIN(I_P); u32x4* dst = (u32x4*)(ws + WS_PB);
            for (size_t i = (size_t)blockIdx.x * NTHR + F.tid; i < (size_t)2 * T * PLE / 8; i += (size_t)F.G * NTHR) dst[i] = pack8(src[2 * i], src[2 * i + 1]);
        }
        SEAM(0);
    }

#pragma clang loop unroll(full)
    for (int L = 0; L < 2; ++L) {
        const int pb = 1 + L * PH_PER_LAYER;
        unsigned char* wl = ws + WS_W + (size_t)L * WL_SIZE;
        if (SITE_ON(0) && IN(pb + 0)) { if (L == 0) phase_rmsnorm<false, false>(F, AIN(I_X), AIN(I_GMIX), HB, X, ws + WS_PP);
            if (L == 0) SEAM(pb + 0); }
        if (SITE_ON(1) && IN(pb + 1)) {
            const unsigned long long* ssq1 = (L == 0) ? nullptr : (const unsigned long long*)(ws + WS_CTL + CTL_SS1); const bf16* Ain = (L == 0) ? HB : X; const bf16* Ain8 = (const bf16*)(L == 0 ? ws + WS_PP : ws + WS_POOLED);
            { PIn P; P.so.init(T / 256, 21, F.G, c); P.K = D; P.lda = D; P.ldb = D; P.A = Ain; P.Bt = (const bf16*)(wl + WL_WIN); P.Zo = Z; P.ssq = ssq1;
              pg8::gemm_phase(F.lds, P); if ((DUP_MASK & 64) && L == 1) pg8::gemm_phase(F.lds, P); }
            { PInVT P; P.so.init(T / 256, 8, F.G, c); P.K = D; P.lda = D; P.ldb = D; P.A = Ain; P.Bt = (const bf16*)(wl + WL_WIN); P.SVTo = SVT; P.GVTo = GVT; P.ssq = ssq1;
              pg8::gemm_phase(F.lds, P); }
            { PGates P; P.so.init(T / 256, GC / 256, F.G, c); P.K = D / 2; P.lda = D / 2; P.ldb = D / 2; P.A = Ain8; P.Bt = (const bf16*)(wl + WL_WBG8); P.Go = GATES; P.bias = AIN(I_BBG) + L * GC; P.ssq = ssq1;
              pg8::gemm_phase(F.lds, P); }
            SEAM(pb + 1);
        }
        if (SITE_ON(2) && IN(pb + 2)) {             phase_postproj(F, Z, AIN(I_SBGQ) + L * 128, AIN(I_SBGK) + L * 128, POOLED, SVT, GVT, false, true, Z + ZSQ, ZC);
            if ((DUP_MASK & 8) && L == 1) { __syncthreads(); phase_postproj(F, Z, AIN(I_SBGQ) + L * 128, AIN(I_SBGK) + L * 128, POOLED, SVT, GVT, false, true, Z + ZSQ, ZC); }
            SEAM(pb + 2); }
        if (SITE_ON(3) && IN(pb + 3)) {
            if (SUB_ON(0)) { PPool P; P.so.init(T / 256, 4, F.G, c); P.K = 256; P.lda = 1024; P.ldb = 256; P.A = POOLED; P.Bt = (const bf16*)(wl + WL_POOL); P.Zo = Z; P.scale = AIN(I_POOLS) + L * 1024;
              pg8::gemm_phase(F.lds, P); if ((DUP_MASK & 128) && L == 1) pg8::gemm_phase(F.lds, P); }
            if (SUB_ON(1)) { PBf16<false> P; P.so.init(T / 256, D / 256, F.G, c); P.K = PLE; P.lda = PLE; P.ldb = PLE; P.A = (const bf16*)(ws + WS_PB) + (size_t)L * T * PLE; P.Bt = wl + WL_PLEP; P.O = PP; P.ldo = D; P.tile_e = nullptr; P.rw = nullptr;
              pg8::gemm_phase(F.lds, P); if ((DUP_MASK & 128) && L == 1) pg8::gemm_phase(F.lds, P); }
            __syncthreads();
            if ((DUP_MASK & 2048) && L == 1) phase_sb(F, Z, SVT, POOLED, 1024, 0, AIN(I_SBGQ) + L * 128, AIN(I_SBGK) + L * 128);
            if (SUB_ON(2)) phase_sb(F, Z, SVT, Z, ZC, ZSQ, AIN(I_SBGQ) + L * 128, AIN(I_SBGK) + L * 128);
            __syncthreads();
            if (SUB_ON(3)) phase_gla1(F, Z, GVT, AIN(I_GLAWLR) + L * 16 * 512, AIN(I_GLABLR) + L * 512, SBUF, DBUF);
            if ((DUP_MASK & 16) && L == 1) phase_gla1(F, Z, GVT, AIN(I_GLAWLR) + L * 16 * 512, AIN(I_GLABLR) + L * 512, SBUF, DBUF);
            SEAM(pb + 3);
        }
        if (SITE_ON(4) && IN(pb + 4)) { phase_gla2(F, SBUF, DBUF, SBUF); SEAM(pb + 4); }
        if (SITE_ON(5) && IN(pb + 5)) { if ((DUP_MASK & 8192) && L == 1) phase_gla3(F, Z, GVT, AIN(I_GLAWLR) + L * 16 * 512, AIN(I_GLABLR) + L * 512, AIN(I_GLAGOUT) + L * 256, SBUF, POOLED, 1024, 0, G3_DUP_MODE);
            phase_gla3(F, Z, GVT, AIN(I_GLAWLR) + L * 16 * 512, AIN(I_GLABLR) + L * 512, AIN(I_GLAGOUT) + L * 256, SBUF, Z, ZC, ZGR); SEAM(pb + 5); }
        if (SITE_ON(6) && IN(pb + 6)) {
            PUp P; P.so.init(T / 256, D / 256, F.G, c); P.K = 1024; P.lda = ZC; P.ldb = 1024; P.Zi = Z; P.Wup = (const bf16*)(wl + WL_WUP); P.Gi = GATES; P.Mo = HB;
            pg8::gemm_phase(F.lds, P); if ((DUP_MASK & 1024) && L == 1) pg8::gemm_phase(F.lds, P); SEAM(pb + 6);
        }
        if (SITE_ON(7) && IN(pb + 7)) {
            PResid<0> P; P.so.init(T / 256, D / 256, F.G, c); P.K = D; P.lda = D; P.ldb = D; P.A = HB; P.Bt = (const bf16*)(wl + WL_WO); P.X = X; P.XB = nullptr; P.PPi = nullptr; P.OUT = nullptr; P.fin = false; P.ssq = (L == 0) ? (unsigned long long*)(ws + WS_CTL + CTL_SS0) : nullptr; P.X8 = nullptr;
            pg8::gemm_phase(F.lds, P); SEAM(pb + 7);
        }
        if (SITE_ON(8) && IN(pb + 8)) {
            if (L == 1) {
                phase_rmsnorm_route(F, X, AIN(I_GFFN) + L * D, HB, AIN(I_ROUTER), SEL, SELW, CNT, AIN(I_MW1), AIN(I_MW3), AIN(I_MW2), ws + WS_WMOE);
                SEAM(pb + 8);
            }
        }
        if (L == 0) {
            if (SITE_ON(9) && IN(pb + 9)) {
                constexpr int DV = DENSE_FP8 ? 2 : 1;
                PSwiglu<false, DENSE_FP8 != 0, (DENSE_FP8 != 0) || (DENSE2_FP8 != 0)> P; P.so.init(T / 256, DFF / 128, F.G, c); P.K = D / DV; P.lda = D / DV; P.ldb = D / DV; P.A = (const unsigned char*)X; P.Bt = ws + WS_FFN13; P.O = ws + WS_ACT; P.tile_e = nullptr; P.rowtok = nullptr; P.ssq = (const unsigned long long*)(ws + WS_CTL + CTL_SS0);
                pg8::gemm_phase(F.lds, P); if (DUP_MASK & 1) pg8::gemm_phase(F.lds, P); SEAM(pb + 9);
            }
            if (SITE_ON(10) && IN(pb + 10)) {
                constexpr int DV = (DENSE_FP8 || DENSE2_FP8) ? 2 : 1;
                PResid<1, (DENSE_FP8 != 0) || (DENSE2_FP8 != 0)> P; P.so.init(T / 256, D / 256, F.G, c); P.K = DFF / DV; P.lda = DFF / DV; P.ldb = DFF / DV; P.A = (const bf16*)(ws + WS_ACT); P.Bt = (const bf16*)(ws + WS_FFN2); P.X = X; P.XB = HB; P.PPi = nullptr; P.OUT = nullptr; P.fin = false; P.ssq = nullptr; P.X8 = nullptr;
                pg8::gemm_phase(F.lds, P); SEAM(pb + 10);
            }
        } else {
            const int kb = pb + 9;
            int* ROWTOK = (int*)(ws + WS_MISC + MISC_ROWTOK);
            if (SITE_ON(11) && IN(kb + 0)) { phase_moe_pos(F, SEL, SELW, CNT, SLOT, ROWW, TILE_E, ROWTOK); SEAM(kb + 0); }
            if (SITE_ON(12) && IN(kb + 1)) {
                const int ntiles = TILE_E[0];
                PSwiglu<true> P; P.so.init(ntiles, DFF / 128, F.G, c); P.K = D / 2; P.lda = D / 2; P.ldb = D / 2; P.A = (const unsigned char*)HB; P.Bt = ws + WS_WMOE; P.O = ws + WS_ACTS; P.tile_e = TILE_E; P.rowtok = ROWTOK; P.ssq = nullptr;
                pg8::gemm_phase(F.lds, P); if (DUP_MASK & 256) pg8::gemm_phase(F.lds, P); SEAM(kb + 1);
            }
            if (SITE_ON(13) && IN(kb + 2)) {
                const int ntiles = TILE_E[0];
                PBf16<true, true> P; P.so.init(ntiles, D / 256, F.G, c); P.K = DFF / 2; P.lda = DFF / 2; P.ldb = DFF / 2; P.A = (const bf16*)(ws + WS_ACTS); P.Bt = ws + WS_WMOE + WMOE_W2; P.O = (bf16*)(ws + WS_YSORT); P.ldo = D;
                P.tile_e = TILE_E; P.rw = ROWW;
                pg8::gemm_phase(F.lds, P); if (DUP_MASK & 512) pg8::gemm_phase(F.lds, P); SEAM(kb + 2);
            }
            if (SITE_ON(14) && IN(kb + 3)) { phase_moe_combine(F, SLOT, (const bf16*)(ws + WS_YSORT), X, HB); SEAM(kb + 3); }
        }
        if (SITE_ON(17) && IN(pb + 17)) {
            PResid<2, true> P; P.so.init(T / 256, D / 256, F.G, c); P.K = D / 2; P.lda = D / 2; P.ldb = D / 2; P.A = HB; P.Bt = (const bf16*)(wl + WL_PLEG); P.X = X; P.XB = nullptr; P.PPi = PP; P.OUT = OUTF; P.fin = (L == 1); P.ssq = (L == 0) ? (unsigned long long*)(ws + WS_CTL + CTL_SS1) : nullptr; P.X8 = (L == 0) ? ws + WS_POOLED : nullptr;
            pg8::gemm_phase(F.lds, P); SEAM(pb + 17);
        }
    }
#if FP8_SELFTEST
    if (blockIdx.x == 0 && threadIdx.x == 0 && ctl[40000] != 1u) OUTF[0] = 1000.0f;
#endif
    if (DBG_TIME_MASK != 0ull && blockIdx.x == 0 && threadIdx.x == 0) {
        const unsigned long long* st = (const unsigned long long*)(ctl + 32768); unsigned long long prev = st[0], sum = 0ull;
        for (int k = 0; k < NPH; ++k) { const unsigned long long e = st[k + 1]; if (e != 0ull) { if ((DBG_TIME_MASK >> k) & 1ull) sum += e - prev; prev = e; } }
        OUTF[0] = (float)sum * DBG_TIME_SCALE;
    }
#undef IN
#undef SEAM
}

extern "C" void kernel_launch(void* const* d_in, const int* in_sizes, int n_in, void* d_out, int out_size, void* d_ws, size_t ws_size, hipStream_t stream) {
    static int grid = 0;
    if (grid == 0) {
        if (n_in != 27 || in_sizes[0] != T * D || out_size != T * D || ws_size < WS_END + 128 * MiB) { fprintf(stderr, "kernel_launch: shape/workspace mismatch (n_in %d, in0 %d, out %d, ws %zu < %zu)\n", n_in, n_in > 0 ? in_sizes[0] : -1, out_size, ws_size, (size_t)WS_END); grid = -1; return; }
        int dev = 0, cus = 0, per_cu = 0;
        if (hipGetDevice(&dev) != hipSuccess || hipDeviceGetAttribute(&cus, hipDeviceAttributeMultiprocessorCount, dev) != hipSuccess) { grid = -1; return; }
        if (hipFuncSetAttribute((const void*)fwd, hipFuncAttributeMaxDynamicSharedMemorySize, LDS_BYTES) != hipSuccess) { fprintf(stderr, "kernel_launch: hipFuncSetAttribute failed\n"); grid = -1; return; }
        if (hipOccupancyMaxActiveBlocksPerMultiprocessor(&per_cu, (const void*)fwd, NTHR, LDS_BYTES) != hipSuccess || per_cu < 1) { fprintf(stderr, "kernel_launch: occupancy query says %d blocks per CU\n", per_cu); }
        (void)hipGetLastError();
        if (cus < 256) { fprintf(stderr, "kernel_launch: needs >= 256 CUs (got %d)\n", cus); grid = -1; return; }
        grid = 256;
    }
    if (grid < 0) return;
    (void)hipMemsetAsync((char*)d_ws + WS_CTL, 0, CTL_ZERO_BYTES, stream);
    Args a{};
    for (int i = 0; i < 27; ++i) a.in[i] = (const float*)d_in[i];
    a.out = (float*)d_out; a.ws = (unsigned char*)d_ws;
#if MK_PER_PHASE
    for (int ph = 0; ph < NPH; ++ph) {
        if ((ph >= 1 + 11 && ph <= 1 + 16) || (ph >= 19 + 13 && ph <= 19 + 16)) continue;
        a.ph_lo = ph; a.ph_hi = ph + 1;
        hipLaunchKernelGGL(fwd, dim3(grid), dim3(NTHR), LDS_BYTES, stream, a);
    }
#else
    a.ph_lo = 0; a.ph_hi = NPH;
    hipLaunchKernelGGL(fwd, dim3(grid), dim3(NTHR), LDS_BYTES, stream, a);
#endif
    const hipError_t le = hipPeekAtLastError();
    if (le != hipSuccess) fprintf(stderr, "kernel_launch: launch failed: %s\n", hipGetErrorName(le));
}
```

```cpp
#include <hip/hip_runtime.h>
#include <cstdio>
#include <cstdint>

#ifndef MK_PER_PHASE
#define MK_PER_PHASE 0
#endif

#ifndef DBG_TIME_MASK
#define DBG_TIME_MASK 0ull
#endif
#ifndef DBG_TIME_SCALE
#define DBG_TIME_SCALE 0.01f
#endif
#ifndef DUP_MASK
#define DUP_MASK 0
#endif
#ifndef FP8_SELFTEST
#define FP8_SELFTEST 0
#endif
#ifndef DENSE_FP8
#define DENSE_FP8 0
#endif
#ifndef DENSE2_FP8
#define DENSE2_FP8 1
#endif
#ifndef G3_DUP_MODE
#define G3_DUP_MODE 0
#endif
#define LAS __attribute__((address_space(3)))
#define GAS __attribute__((address_space(1)))
typedef unsigned short bf16;
typedef short bf16x8 __attribute__((ext_vector_type(8)));
typedef float f32x2 __attribute__((ext_vector_type(2)));
typedef float f32x4 __attribute__((ext_vector_type(4)));
typedef float f32x16 __attribute__((ext_vector_type(16)));
typedef unsigned u32x2 __attribute__((ext_vector_type(2)));
typedef unsigned u32x4 __attribute__((ext_vector_type(4)));
typedef __bf16 bf16x2_t __attribute__((ext_vector_type(2)));
typedef int i32x4 __attribute__((ext_vector_type(4)));
typedef int i32x8 __attribute__((ext_vector_type(8)));

#define DI __device__ __forceinline__
DI unsigned pk2(float lo, float hi) { f32x2 v = {lo, hi}; bf16x2_t b = __builtin_convertvector(v, bf16x2_t); return __builtin_bit_cast(unsigned, b); }
DI unsigned pk4_fp8(float a, float b, float c, float d) {
    a = __builtin_amdgcn_fmed3f(a, -448.f, 448.f); b = __builtin_amdgcn_fmed3f(b, -448.f, 448.f); c = __builtin_amdgcn_fmed3f(c, -448.f, 448.f); d = __builtin_amdgcn_fmed3f(d, -448.f, 448.f);
    int w = 0; w = __builtin_amdgcn_cvt_pk_fp8_f32(a, b, w, false); w = __builtin_amdgcn_cvt_pk_fp8_f32(c, d, w, true); return (unsigned)w; }
DI float bflo(unsigned u) { return __uint_as_float(u << 16); }
DI float bfhi(unsigned u) { return __uint_as_float(u & 0xffff0000u); }
DI float bf2f(bf16 b) { return __uint_as_float(((unsigned)b) << 16); }
DI u32x4 pack8(const f32x4& a, const f32x4& b) { u32x4 w; w.x = pk2(a.x, a.y); w.y = pk2(a.z, a.w); w.z = pk2(b.x, b.y); w.w = pk2(b.z, b.w); return w; }
DI void unpack8(const u32x4& w, f32x4& a, f32x4& b) { a = (f32x4){bflo(w.x), bfhi(w.x), bflo(w.y), bfhi(w.y)}; b = (f32x4){bflo(w.z), bfhi(w.z), bflo(w.w), bfhi(w.w)}; }
DI float fexp2(float x) { return __builtin_amdgcn_exp2f(x); }
DI float frcp(float x) { return __builtin_amdgcn_rcpf(x); }
DI float flog2(float x) { return __builtin_amdgcn_logf(x); }
DI float frsq(float x) { return __builtin_amdgcn_rsqf(x); }
constexpr float LOG2E = 1.4426950408889634f, LN2 = 0.6931471805599453f;
DI float fsigmoid(float x) { return frcp(1.0f + fexp2(-x * LOG2E)); }
DI float fsilu(float x) { return x * fsigmoid(x); }
DI float flogsigmoid(float x) { return fminf(x, 0.f) - LN2 * flog2(1.0f + fexp2(-fabsf(x) * LOG2E)); }
#define LDS_WAIT() asm volatile("s_waitcnt lgkmcnt(0)" ::: "memory")
#define VM_WAIT() asm volatile("s_waitcnt vmcnt(0)" ::: "memory")

constexpr int NB = 4, SEQ = 8192, T = NB * SEQ, D = 2048;
constexpr int IN_COLS = 7184;
constexpr int ZC = 7424, GC = 6144, NIN = ZC + GC;
constexpr int ZU = 0, ZSQ = 1024, ZSK = 2048, ZSV = 3072, ZGQ = 4096, ZGK = 4608, ZGV = 5120, ZGR = 6144, ZLR = 7168;
constexpr int DFF = 5632, NE = 8, PLE = 256;
constexpr float EPS = 1e-6f;
constexpr int NWAVES = 8, NTHR = 512;
constexpr int SORT_ROWS = 2 * T + NE * 256, SORT_TILES = SORT_ROWS / 256;

constexpr size_t MiB = 1u << 20;
constexpr size_t WS_CTL = 0, CTL_ZERO_BYTES = 1 * MiB;
constexpr size_t WS_MISC = 1 * MiB;
constexpr size_t MISC_SEL = 0, MISC_SELW = 128 * 1024, MISC_SLOT = 384 * 1024, MISC_CNT = 640 * 1024, MISC_ROWW = 648 * 1024, MISC_TILE = 920 * 1024, MISC_ROWTOK = 1024 * 1024  ;
constexpr size_t WS_DBUF = 3 * MiB;
constexpr size_t WS_W = 4 * MiB;
constexpr size_t WL_WIN = 0, WL_WBG8 = 29 * MiB  , WL_POOL = 53 * MiB, WL_WUP = WL_POOL + MiB / 2, WL_WO = WL_WUP + 12 * MiB, WL_PLEP = WL_WO + 8 * MiB, WL_PLEG = WL_PLEP + 1 * MiB, WL_SIZE = WL_PLEG + 8 * MiB;
constexpr size_t WS_FFN13 = WS_W + 2 * WL_SIZE, WS_FFN2 = WS_FFN13 + 44 * MiB, WS_PB = WS_FFN2 + 22 * MiB;
constexpr size_t WS_HB = WS_PB + 32 * MiB;
constexpr size_t WS_PP = WS_HB + 128 * MiB;
constexpr size_t WS_BR = WS_PP + 128 * MiB;
constexpr size_t WS_Z = WS_BR, WS_GATES = WS_Z + 464 * MiB, WS_POOLED = WS_GATES + 384 * MiB, WS_SVT = WS_POOLED + 64 * MiB, WS_GVT = WS_SVT + 64 * MiB, WS_SBUF = WS_GVT + 64 * MiB;
constexpr size_t WS_ACT = WS_BR;
constexpr size_t WS_WMOE = WS_BR, WMOE_E = 33 * MiB, WMOE_W2 = 22 * MiB;
constexpr size_t WS_ASORT = WS_WMOE + 264 * MiB, WS_ACTS = WS_ASORT + 132 * MiB, WS_YSORT = WS_ACTS + 363 * MiB;
constexpr size_t WS_END = WS_BR + 1174 * MiB;
static_assert(WL_SIZE == 82 * MiB + MiB / 2, "layer weight block");
static_assert(WS_SBUF + 128 * MiB <= WS_END, "mixer region inside the MoE region's extent");
static_assert((size_t)T * ZC * 2 == 464 * MiB && (size_t)T * GC * 2 == 384 * MiB && (size_t)SORT_ROWS * DFF == 363 * MiB && (size_t)SORT_ROWS * D == 132 * MiB && WS_YSORT + (size_t)SORT_ROWS * D * 2 <= WS_END, "sizes");
constexpr int CW_TMO = 0, CW_BAR = 4096;
constexpr size_t CTL_SS0 = 256 * 1024, CTL_SS1 = 512 * 1024;
constexpr float SSQ_FIX = 16777216.0f, SSQ_UNFIX = 1.0f / 16777216.0f;

constexpr int RING_BYTES = 131072;
constexpr int MISC_OFF = RING_BYTES;
constexpr int JUNK_OFF = RING_BYTES + 1024;
constexpr int LDS_BYTES = RING_BYTES + 1024 + 2048;

namespace pg8 {
constexpr int BM = 256, BK = 64, HALF = 128, HTB = HALF * BK * 2, NXCD = 8, WGM = 4;
__host__ __device__ __forceinline__ int lds_byte(int r, int c) { const int st = (r >> 4) * 2 + (c >> 5), rr = r & 15, cc = c & 31, ob = rr * 64 + cc * 2; return st * 1024 + (ob ^ (((ob >> 9) & 1) << 5)); }
__host__ __device__ __forceinline__ void stage_rc(int b, int& R, int& C) { const int st = b / 1024, sb = b % 1024, swz = sb ^ (((sb >> 9) & 1) << 5); R = (st >> 1) * 16 + swz / 64; C = (st & 1) * 32 + (swz % 64) / 2; }
__host__ __device__ __forceinline__ int perm32(int rho) { const int n = rho >> 4, i = rho & 15; return 8 * (i >> 2) + 4 * n + (i & 3); }
struct Unit { int pm, pn, aux; };
struct StaticOrder {
    int nM, nN, nwg, G, c;
    __device__ void init(int nM_, int nN_, int G_, int c_) { nM = nM_; nN = nN_; nwg = nM * nN; G = G_; c = c_; }
    __device__ bool tile(int i, int& pm, int& pn) const {
        const long L = (long)i * G + c; if (L >= nwg) return false;
        int wgid = (int)L; { const int q = nwg / NXCD, r = nwg % NXCD, xcd = wgid % NXCD, off = wgid / NXCD; wgid = (xcd < r ? xcd * (q + 1) : r * (q + 1) + (xcd - r) * q) + off; }
        const int nig = WGM * nN, gid = wgid / nig, fm = gid * WGM, gsz = (nM - fm) < WGM ? (nM - fm) : WGM;
        pm = fm + ((wgid % nig) % gsz); pn = (wgid % nig) / gsz; return true;
    }
};
template <class P>
__device__ __forceinline__ void gemm_phase(LAS unsigned char* lds, const P& S) {
    int tid_ = threadIdx.x; asm volatile("" : "+v"(tid_));
    const int tid = tid_, wid = __builtin_amdgcn_readfirstlane(tid >> 6), lane = tid & 63, wr = wid >> 2, wc = wid & 3, fr = lane & 15, fq = lane >> 4;
    const int K = S.K, nt = K / BK;
    unsigned voffA[2], voffB[2];
#pragma unroll
    for (int i = 0; i < 2; ++i) { int R, C; stage_rc(tid * 16 + i * 8192, R, C); const int Rb = P::PERM ? ((R & ~31) + perm32(R & 31)) : R;
        voffA[i] = (unsigned)(R * S.lda + C) * 2u; voffB[i] = (unsigned)(Rb * S.ldb + C) * 2u; }
    unsigned gcur[2][2] = {{0u, 0u}, {0u, 0u}}, gnxt[2][2] = {{0u, 0u}, {0u, 0u}};
    const size_t kstep = (size_t)(BK * 2);
    const size_t hstepA = (size_t)HALF * S.lda * 2, hstepB = (size_t)HALF * S.ldb * 2;
    const unsigned ldsw = (unsigned)wid * 1024u;
    const int aoff = lds_byte(wr * 64 + fr, fq * 8), boff = lds_byte(wc * 32 + fr, fq * 8);
#define PG8_SA(b, h) (((b) * 2 + (h)) * HTB)
#define PG8_SB(b, h) ((4 + (b) * 2 + (h)) * HTB)
#define PG8_STAGE(bufoff, gbase, voff) do { _Pragma("unroll") for (int _i = 0; _i < 2; ++_i) \
        __builtin_amdgcn_global_load_lds((const unsigned*)((const char*)(gbase) + (voff)[_i]), (LAS unsigned*)(lds + (bufoff) + ldsw + _i * 8192), 16, 0, 0); } while (0)
#define PG8_STAGE_A(bufoff, gptr, h, isnext) do { if constexpr (P::GATHER) { _Pragma("unroll") for (int _i = 0; _i < 2; ++_i) \
        __builtin_amdgcn_global_load_lds((const unsigned*)((const char*)(gptr) + ((isnext) ? gnxt[h][_i] : gcur[h][_i])), (LAS unsigned*)(lds + (bufoff) + ldsw + _i * 8192), 16, 0, 0); } \
        else { PG8_STAGE(bufoff, (gptr) + ((h) ? hstepA : 0), voffA); } } while (0)
#define PG8_LDA(dst, b, h) do { _Pragma("unroll") for (int m = 0; m < 4; ++m) _Pragma("unroll") for (int k = 0; k < 2; ++k) dst[m][k] = *(const LAS bf16x8*)(lds + PG8_SA(b, h) + aoff + m * 2048 + k * 1024); } while (0)
#define PG8_LDB(dst, b, h) do { _Pragma("unroll") for (int n = 0; n < 2; ++n) _Pragma("unroll") for (int k = 0; k < 2; ++k) dst[n][k] = *(const LAS bf16x8*)(lds + PG8_SB(b, h) + boff + n * 2048 + k * 1024); } while (0)
#define PG8_CAT(x) __builtin_shufflevector(__builtin_bit_cast(i32x4, (x)[0]), __builtin_bit_cast(i32x4, (x)[1]), 0, 1, 2, 3, 4, 5, 6, 7)
#define PG8_MMA(ai, bj, At, Bt) do { __builtin_amdgcn_s_setprio(1); _Pragma("unroll") for (int m = 0; m < 4; ++m) _Pragma("unroll") for (int n = 0; n < 2; ++n) { \
        if constexpr (P::FP8) { const i32x8 b8_ = PG8_CAT(Bt[n]), a8_ = PG8_CAT(At[m]); \
            asm volatile("v_mfma_scale_f32_16x16x128_f8f6f4 %0, %1, %2, %0, %3, %4 op_sel_hi:[0,0,0]" : "+v"(acc[ai][bj][m][n]) : "v"(b8_), "v"(a8_), "v"(sclB), "v"(sclA)); } \
        else if constexpr (P::SWAPMM) { _Pragma("unroll") for (int k = 0; k < 2; ++k) acc[ai][bj][m][n] = __builtin_amdgcn_mfma_f32_16x16x32_bf16(At[m][k], Bt[n][k], acc[ai][bj][m][n], 0, 0, 0); } \
        else { _Pragma("unroll") for (int k = 0; k < 2; ++k) acc[ai][bj][m][n] = __builtin_amdgcn_mfma_f32_16x16x32_bf16(Bt[n][k], At[m][k], acc[ai][bj][m][n], 0, 0, 0); } } \
        __builtin_amdgcn_s_setprio(0); } while (0)
#define PG8_WAIT_V(n) asm volatile("s_waitcnt vmcnt(" #n ")" ::: "memory")
#define PG8_WAIT_L(n) asm volatile("s_waitcnt lgkmcnt(" #n ")" ::: "memory")
#define PG8_BAR __builtin_amdgcn_s_barrier()
#define PG8_SCHED __builtin_amdgcn_sched_barrier(0)
    Unit cur, nxt; int ui = 0;
    if (!S.next(0, cur)) return;
    int sclA = 0x7f7f7f7f, sclB = P::BSCALE; asm volatile("" : "+v"(sclA), "+v"(sclB));
    f32x4 acc[2][2][4][2];
#pragma unroll
    for (int a = 0; a < 2; ++a)
#pragma unroll
        for (int b = 0; b < 2; ++b)
#pragma unroll
            for (int m = 0; m < 4; ++m)
#pragma unroll
                for (int n = 0; n < 2; ++n) acc[a][b][m][n] = (f32x4){0.f, 0.f, 0.f, 0.f};
    bf16x8 At[4][2], B0[2][2], B1[2][2];
    const char* cA = S.a_base(cur); const char* cB = S.b_base(cur);
    if constexpr (P::GATHER) {
#pragma unroll
        for (int h = 0; h < 2; ++h)
#pragma unroll
            for (int i = 0; i < 2; ++i) { int R, C; stage_rc(tid * 16 + i * 8192, R, C); gcur[h][i] = S.row_off(cur, R + 128 * h) + (unsigned)(C * 2); } }
    PG8_STAGE(PG8_SB(0, 0), cB, voffB); PG8_STAGE(PG8_SB(0, 1), cB + hstepB, voffB); PG8_STAGE_A(PG8_SA(0, 0), cA, 0, false); PG8_STAGE_A(PG8_SA(0, 1), cA, 1, false);
    if (wr == 1) PG8_BAR;
    PG8_WAIT_V(2); PG8_BAR;
    PG8_STAGE(PG8_SB(1, 0), cB + kstep, voffB); PG8_STAGE_A(PG8_SA(1, 0), cA + kstep, 0, false); PG8_STAGE(PG8_SB(1, 1), cB + hstepB + kstep, voffB);
    PG8_WAIT_V(6); PG8_BAR;
    for (;;) {
        const bool has_next = S.next(ui + 1, nxt);
        const char* nA = has_next ? S.a_base(nxt) : cA; const char* nB = has_next ? S.b_base(nxt) : cB;
        if constexpr (P::GATHER) {
#pragma unroll
            for (int h = 0; h < 2; ++h)
#pragma unroll
                for (int i = 0; i < 2; ++i) { int R, C; stage_rc(tid * 16 + i * 8192, R, C); gnxt[h][i] = has_next ? S.row_off(nxt, R + 128 * h) + (unsigned)(C * 2) : gcur[h][i]; } }
        for (int t = 0; t < nt; t += 2) {
            const bool last = (t == nt - 2);
            const char* a1 = cA + (size_t)(t + 1) * kstep;
            const char* a2 = last ? nA : cA + (size_t)(t + 2) * kstep; const char* b2 = last ? nB : cB + (size_t)(t + 2) * kstep;
            const char* a3 = a2 + kstep; const char* b3 = b2 + kstep;
            PG8_LDB(B0, 0, 0); PG8_LDB(B1, 0, 1); PG8_SCHED; PG8_LDA(At, 0, 0); PG8_STAGE_A(PG8_SA(1, 1), a1, 1, false);
            PG8_WAIT_V(8); PG8_WAIT_L(0); PG8_BAR; PG8_MMA(0, 0, At, B0); PG8_MMA(0, 1, At, B1); PG8_BAR; PG8_SCHED;
            PG8_LDA(At, 0, 1); PG8_STAGE(PG8_SB(0, 0), b2, voffB); PG8_STAGE(PG8_SB(0, 1), b2 + hstepB, voffB); PG8_STAGE_A(PG8_SA(0, 0), a2, 0, last);
            PG8_WAIT_V(8); PG8_WAIT_L(0); PG8_BAR; PG8_MMA(1, 0, At, B0); PG8_MMA(1, 1, At, B1); PG8_BAR; PG8_SCHED;
            PG8_LDB(B0, 1, 0); PG8_LDB(B1, 1, 1); PG8_SCHED; PG8_LDA(At, 1, 0); PG8_STAGE_A(PG8_SA(0, 1), a2, 1, last);
            PG8_WAIT_V(8); PG8_WAIT_L(0); PG8_BAR; PG8_MMA(0, 0, At, B0); PG8_MMA(0, 1, At, B1); PG8_BAR; PG8_SCHED;
            PG8_LDA(At, 1, 1); PG8_STAGE(PG8_SB(1, 0), b3, voffB); PG8_STAGE(PG8_SB(1, 1), b3 + hstepB, voffB); PG8_STAGE_A(PG8_SA(1, 0), a3, 0, last);
            PG8_WAIT_V(8); PG8_WAIT_L(0); PG8_BAR; PG8_MMA(1, 0, At, B0); PG8_MMA(1, 1, At, B1); PG8_BAR; PG8_SCHED;
        }
        if constexpr (P::PREFETCH) S.pre_epi(cur, wid, lane, lds);
        if (wr == 0) PG8_BAR;
        if constexpr (P::FP8) asm volatile("s_nop 15\n\ts_nop 15\n\ts_nop 7" ::: "memory");
        const bool zero = S.epi(acc, cur, wr, wc, fr, fq);
        if (!has_next) break;
        if (zero) {
#pragma unroll
        for (int a = 0; a < 2; ++a)
#pragma unroll
            for (int b = 0; b < 2; ++b)
#pragma unroll
                for (int m = 0; m < 4; ++m)
#pragma unroll
                    for (int n = 0; n < 2; ++n) acc[a][b][m][n] = (f32x4){0.f, 0.f, 0.f, 0.f};
        }
        cur = nxt; cA = nA; cB = nB; ++ui;
        if constexpr (P::GATHER) {
#pragma unroll
            for (int h = 0; h < 2; ++h)
#pragma unroll
                for (int i = 0; i < 2; ++i) gcur[h][i] = gnxt[h][i]; }
        if (wr == 1) PG8_BAR;
    }
    PG8_WAIT_V(0);
    PG8_BAR;
#undef PG8_SA
#undef PG8_SB
#undef PG8_STAGE
#undef PG8_LDA
#undef PG8_STAGE_A
#undef PG8_LDB
#undef PG8_MMA
#undef PG8_CAT
#undef PG8_WAIT_V
#undef PG8_WAIT_L
#undef PG8_BAR
#undef PG8_SCHED
}
}

#define XB_TMO      128
#define XB_XCNT(j)  (256  + 64 * (j))
#define XB_XSUB(j)  (1280 + 64 * (j))
#define XB_XGEN(j)  (2304 + 64 * (j))
#define XB_TOP      3328
#define XB_TOPGEN   3392
#define XCD_BAR_WORDS 3456
#define XB_SPIN_CAP (1u << 20)
__device__ __forceinline__ unsigned xb_ld(unsigned* p)              { return __hip_atomic_load(p, __ATOMIC_RELAXED, __HIP_MEMORY_SCOPE_AGENT); }
__device__ __forceinline__ unsigned xb_add(unsigned* p, unsigned v) { return __hip_atomic_fetch_add(p, v, __ATOMIC_RELAXED, __HIP_MEMORY_SCOPE_AGENT); }
__device__ __forceinline__ unsigned xb_xcc_id() { return (unsigned)__builtin_amdgcn_s_getreg((3 << 11) | 20) & 0xFu; }
#define XB_SPIN(cond, bar) do { unsigned _sp = 0; while (cond) { __builtin_amdgcn_s_sleep(1); \
    if ((++_sp & 255u) == 0u) { if (xb_ld(&(bar)[XB_TMO])) break; if (_sp > XB_SPIN_CAP) { atomicAdd(&(bar)[XB_TMO], 1u); break; } } } } while (0)
struct XcdBarrier { unsigned* bar; unsigned x; volatile LAS unsigned* st; };
__device__ __forceinline__ XcdBarrier xcd_barrier_post(unsigned* bar, volatile LAS unsigned* st) {
    XcdBarrier b; b.bar = bar; b.x = xb_xcc_id(); b.st = st;
    if (threadIdx.x == 0) (void)xb_add(&bar[XB_XCNT(b.x)], 1u);
    return b;
}
__device__ __forceinline__ void xcd_barrier_complete(unsigned* bar, unsigned x, unsigned& nloc, unsigned& nx) {
    const unsigned G = gridDim.x * gridDim.y * gridDim.z;
    unsigned sum, cnt, mine, sp = 0u;
    for (;;) {
        sum = 0u; cnt = 0u; mine = 0u;
#pragma unroll
        for (unsigned j = 0; j < 16; ++j) { const unsigned c = xb_ld(&bar[XB_XCNT(j)]); sum += c; cnt += (c > 0u) ? 1u : 0u; mine = (j == x) ? c : mine; }
        if (sum == G) break;
        __builtin_amdgcn_s_sleep(1);
        if ((++sp & 255u) == 0u) { if (xb_ld(&bar[XB_TMO])) break; if (sp > XB_SPIN_CAP) { atomicAdd(&bar[XB_TMO], 1u); break; } }
    }
    nloc = mine > 0u ? mine : 1u; nx = cnt > 0u ? cnt : 1u;
}
__device__ __forceinline__ void xcd_barrier(const XcdBarrier& b) {
    asm volatile("s_waitcnt vmcnt(0)" ::: "memory");
    __syncthreads();
    if (threadIdx.x == 0) {
        unsigned* bar = b.bar; asm volatile("" : "+s"(bar));
        __builtin_amdgcn_s_waitcnt(0);
        unsigned nloc = b.st[0], nx = b.st[1];
        if (nloc == 0u) { xcd_barrier_complete(bar, b.x, nloc, nx); b.st[0] = nloc; b.st[1] = nx; }
        const unsigned old = xb_add(&bar[XB_XSUB(b.x)], 1u);
        const unsigned gen = old / nloc;
        if (old + 1u == (gen + 1u) * nloc) {
            __builtin_amdgcn_fence(__ATOMIC_RELEASE, "agent");
            asm volatile("s_waitcnt vmcnt(0)" ::: "memory");
            const unsigned og = xb_add(&bar[XB_TOP], 1u);
            const unsigned tg = og / nx;
            if (og + 1u == (tg + 1u) * nx) xb_add(&bar[XB_TOPGEN], 1u);
            else XB_SPIN(xb_ld(&bar[XB_TOPGEN]) == tg, bar);
            __builtin_amdgcn_fence(__ATOMIC_ACQUIRE, "agent");
            xb_add(&bar[XB_XGEN(b.x)], 1u);
            asm volatile("s_waitcnt vmcnt(0)" ::: "memory");
        } else {
            XB_SPIN(xb_ld(&bar[XB_XGEN(b.x)]) == gen, bar);
            __builtin_amdgcn_fence(__ATOMIC_ACQUIRE, "agent");
            asm volatile("s_waitcnt vmcnt(0)" ::: "memory");
        }
    }
    __syncthreads();
}

struct Args { const float* in[27]; float* out; unsigned char* ws; int ph_lo, ph_hi; };
enum { I_X = 0, I_P, I_GMIX, I_WIN, I_WBG, I_BBG, I_POOLW, I_POOLS, I_SBGQ, I_SBGK, I_GLAWLR, I_GLABLR, I_GLAGOUT, I_WUPP, I_WUPS, I_WUPG, I_WO, I_GFFN,
       I_FW1, I_FW3, I_FW2, I_ROUTER, I_MW1, I_MW3, I_MW2, I_PLEP, I_PLEG };
struct Frame {
    LAS unsigned char* lds;
    int tid, lane, wave, G, vcu, gw, ngw;
};
DI Frame fresh(const Frame& F0) {
    Frame F = F0; int t = F0.tid; asm volatile("" : "+v"(t)); F.tid = t; F.lane = t & 63; F.wave = __builtin_amdgcn_readfirstlane(t >> 6); F.gw = F.vcu * NWAVES + F.wave; return F;
}
DI float wave_sum(float v) {
#pragma unroll
    for (int o = 1; o < 64; o <<= 1) v += __shfl_xor(v, o);
    return v;
}

DI int map_row(int kind, int n, int row_off) {
    if (kind == 1) return n < 6144 ? n : (n < 6160 ? ZLR + (n - 6144) : ZGR + (n - 6160));
    if (kind == 2) return (n >> 7) * 256 + (n & 127);
    if (kind == 3) return (n >> 7) * 256 + 128 + (n & 127);
    return n + row_off;
}
template <bool F8> DI void transpose_item(const float* __restrict__ W, int K, int N, bf16* WT, int kind, int row_off, LAS float* scr, int item, int lane, const float* gk = nullptr) {
    const int nblk = (N + 31) / 32, kb = item / nblk, nb = item % nblk, k0 = 64 * kb, n0 = 32 * nb;
    const int nc = n0 + 4 * (lane & 7);
    f32x4 v[8];
#pragma unroll
    for (int j = 0; j < 8; ++j) v[j] = nc < N ? *(const f32x4*)(W + (size_t)(k0 + 8 * j + (lane >> 3)) * N + nc) : (f32x4){0.f, 0.f, 0.f, 0.f};
    if (gk) {
#pragma unroll
        for (int j = 0; j < 8; ++j) v[j] = v[j] * gk[k0 + 8 * j + (lane >> 3)]; }
#pragma unroll
    for (int j = 0; j < 8; ++j) { LAS float* d = scr + (8 * j + (lane >> 3)) * 33 + 4 * (lane & 7); d[0] = v[j].x; d[1] = v[j].y; d[2] = v[j].z; d[3] = v[j].w; }
    LDS_WAIT(); asm volatile("" ::: "memory");
    const int c = lane & 7;
#pragma unroll
    for (int j = 0; j < 4; ++j) { const int nl = (lane >> 3) + 8 * j; const LAS float* s = scr + (8 * c) * 33 + nl;
        if constexpr (F8) {
            u32x2 o; o.x = pk4_fp8(64.f * s[0 * 33], 64.f * s[1 * 33], 64.f * s[2 * 33], 64.f * s[3 * 33]); o.y = pk4_fp8(64.f * s[4 * 33], 64.f * s[5 * 33], 64.f * s[6 * 33], 64.f * s[7 * 33]);
            if (n0 + nl < N) *(u32x2*)((unsigned char*)WT + (size_t)map_row(kind, n0 + nl, row_off) * K + k0 + 8 * c) = o;
        } else {
        u32x4 o; o.x = pk2(s[0 * 33], s[1 * 33]); o.y = pk2(s[2 * 33], s[3 * 33]); o.z = pk2(s[4 * 33], s[5 * 33]); o.w = pk2(s[6 * 33], s[7 * 33]);
        if (n0 + nl < N) *(u32x4*)(WT + (size_t)map_row(kind, n0 + nl, row_off) * K + k0 + 8 * c) = o; } }
    LDS_WAIT(); asm volatile("" ::: "memory");
}
template <bool F8 = false> DI void convert_matrix(const Frame& F0, const float* W, int K, int N, bf16* WT, int kind, int row_off, int rot, int scr_off = -1, const float* gk = nullptr) {
    const Frame F = fresh(F0);
    LAS float* scr = (LAS float*)(F.lds + (scr_off >= 0 ? scr_off : F.wave * 16384));
    const int nitems = (K / 64) * ((N + 31) / 32);
    int g0 = F.gw - (rot % F.ngw); if (g0 < 0) g0 += F.ngw;
    for (int it = g0; it < nitems; it += F.ngw) transpose_item<F8>(W, K, N, WT, kind, row_off, scr, it, F.lane, gk);
}

template <bool F8, bool XIN16> DI void rms_row(const void* xrow, const float* g, bf16* hrow, bf16* xcopy, int lane, f32x4 (&v)[8], float& rstd, unsigned char* h8row = nullptr) {
    float ss = 0.f;
#pragma unroll
    for (int j = 0; j < 8; ++j) { if constexpr (XIN16) { const u32x2 w = ((const u32x2*)xrow)[lane + 64 * j]; v[j] = (f32x4){bflo(w.x), bfhi(w.x), bflo(w.y), bfhi(w.y)}; } else v[j] = ((const f32x4*)xrow)[lane + 64 * j]; ss += (v[j].x * v[j].x + v[j].y * v[j].y) + (v[j].z * v[j].z + v[j].w * v[j].w); }
    f32x4 gv[8];
#pragma unroll
    for (int j = 0; j < 8; ++j) gv[j] = ((const f32x4*)g)[lane + 64 * j];
    rstd = frsq(wave_sum(ss) * (1.f / D) + EPS);
    u32x2* o8 = (u32x2*)hrow + lane;
#pragma unroll
    for (int j = 0; j < 8; ++j) { const f32x4 gg = gv[j]; if (xcopy) { u32x2 w; w.x = pk2(v[j].x, v[j].y); w.y = pk2(v[j].z, v[j].w); ((u32x2*)xcopy)[lane + 64 * j] = w; }
        v[j] = v[j] * rstd * gg;
        if constexpr (F8) ((unsigned*)hrow)[lane + 64 * j] = pk4_fp8(v[j].x, v[j].y, v[j].z, v[j].w);
        else { u32x2 w; w.x = pk2(v[j].x, v[j].y); w.y = pk2(v[j].z, v[j].w); o8[64 * j] = w; if (h8row) ((unsigned*)h8row)[lane + 64 * j] = pk4_fp8(v[j].x, v[j].y, v[j].z, v[j].w); } }
}
template <bool F8, bool XIN16> DI void phase_rmsnorm(const Frame& F0, const void* X, const float* g, bf16* HB, bf16* xcopy, unsigned char* H8 = nullptr) {
    const Frame F = fresh(F0);
    for (int m = F.gw; m < T; m += F.ngw) { f32x4 v[8]; float rstd; rms_row<F8, XIN16>((const char*)X + (size_t)m * D * (XIN16 ? 2 : 4), g, F8 ? (bf16*)((unsigned char*)HB + (size_t)m * D) : HB + (size_t)m * D, xcopy ? xcopy + (size_t)m * D : nullptr, F.lane, v, rstd, H8 ? H8 + (size_t)m * D : nullptr); }
}
DI void phase_rmsnorm_route(const Frame& F0, const bf16* X, const float* g, bf16* HB, const float* router, int* sel, float* selw, int* cnt, const float* mw1, const float* mw3, const float* mw2, unsigned char* wmoe) {
    const Frame F = fresh(F0);
    LAS float* rl = (LAS float*)F.lds;
    LAS int* sl = (LAS int*)(F.lds + 65536);
    for (int i = F.tid; i < D * NE / 4; i += NTHR) { const f32x4 r = ((const f32x4*)router)[i]; const int col = i >> 1, e0 = 4 * (i & 1);
        rl[(e0 + 0) * D + col] = r.x; rl[(e0 + 1) * D + col] = r.y; rl[(e0 + 2) * D + col] = r.z; rl[(e0 + 3) * D + col] = r.w; }
    __syncthreads();
    const int c = blockIdx.x;
#pragma unroll 1
    for (int half = 0; half < 2; ++half) {
    if ((F.wave >> 2) != half) {
        int rot = 0; const int scr_off = 66560 + (F.wave & 3) * 8448;
        for (int rep = 0; rep < ((DUP_MASK & 2) ? 2 : 1); ++rep)
        for (int e = 0; e < NE; ++e) {
            unsigned char* we = wmoe + (size_t)e * WMOE_E;
            convert_matrix<true>(F, mw1 + (size_t)e * D * DFF, D, DFF, (bf16*)we, 2, 0, rot, scr_off); rot += 32 * 176;
            convert_matrix<true>(F, mw3 + (size_t)e * D * DFF, D, DFF, (bf16*)we, 3, 0, rot, scr_off); rot += 32 * 176;
            convert_matrix<true>(F, mw2 + (size_t)e * DFF * D, DFF, D, (bf16*)(we + WMOE_W2), 0, 0, rot, scr_off); rot += 88 * 64;
        }
    } else
    for (int i = 0; i < 16; ++i) {
        const int lr = F.wave * 16 + i, m = c * 128 + lr;
        f32x4 v[8]; float rstd; rms_row<true, true>(X + (size_t)m * D, g, (bf16*)((unsigned char*)HB + (size_t)m * D), nullptr, F.lane, v, rstd);
        float lg[NE];
#pragma unroll
        for (int e = 0; e < NE; ++e) lg[e] = 0.f;
#pragma unroll
        for (int e = 0; e < NE; ++e)
#pragma unroll
            for (int j = 0; j < 8; ++j) { const f32x4 r = *(const LAS f32x4*)(rl + e * D + 4 * F.lane + 256 * j); lg[e] += (v[j].x * r.x + v[j].y * r.y) + (v[j].z * r.z + v[j].w * r.w); }
#pragma unroll
        for (int e = 0; e < NE; ++e) lg[e] = wave_sum(lg[e]);
        int e1 = 0; float v1 = lg[0];
#pragma unroll
        for (int e = 1; e < NE; ++e) if (lg[e] > v1) { v1 = lg[e]; e1 = e; }
        int e2 = -1; float v2 = -3.0e38f;
#pragma unroll
        for (int e = 0; e < NE; ++e) if (e != e1 && lg[e] > v2) { v2 = lg[e]; e2 = e; }
        const float w1 = frcp(1.0f + fexp2((v2 - v1) * LOG2E)), w2 = 1.0f - w1;
        if (F.lane == 0) { sel[m] = e1 | (e2 << 8); selw[2 * m] = w1; selw[2 * m + 1] = w2; sl[lr] = e1 | (e2 << 8); }
    }
    __syncthreads();
    }
    if (F.tid < NE) { int n = 0; for (int i = 0; i < 128; ++i) { const int s = sl[i]; n += ((s & 255) == F.tid) + ((s >> 8) == F.tid); } cnt[c * NE + F.tid] = n; }
    __syncthreads();
}

DI void phase_postproj(const Frame& F0, bf16* Z, const float* gq, const float* gk, bf16* POOLED, bf16* SVT, bf16* GVT, bool do_norm, bool do_rest, bf16* ndst, int ndld) {
    const Frame F = fresh(F0);
    if (do_norm) for (int m = F.gw; m < T; m += F.ngw) {
        const u32x4* row = (const u32x4*)(Z + (size_t)m * ZC + ZSQ); u32x4* drow = (u32x4*)(ndst + (size_t)m * ndld);
#pragma unroll
        for (int j = 0; j < 4; ++j) {
            const int ch = F.lane + 64 * j; u32x4 w = row[ch];
            float f[8] = {bflo(w.x), bfhi(w.x), bflo(w.y), bfhi(w.y), bflo(w.z), bfhi(w.z), bflo(w.w), bfhi(w.w)};
            float ss = 0.f;
#pragma unroll
            for (int q = 0; q < 8; ++q) ss += f[q] * f[q];
            ss += __shfl_xor(ss, 1); ss += __shfl_xor(ss, 2); ss += __shfl_xor(ss, 4); ss += __shfl_xor(ss, 8);
            float sc = frsq(ss * (1.f / 128.f) + EPS); if (j < 2) sc *= 0.08838834764831845f * LOG2E;
            const float* gg = (j < 2 ? gq : gk) + (ch & 15) * 8;
            const f32x4 g0 = *(const f32x4*)gg, g1 = *(const f32x4*)(gg + 4);
            w.x = pk2(f[0] * sc * g0.x, f[1] * sc * g0.y); w.y = pk2(f[2] * sc * g0.z, f[3] * sc * g0.w); w.z = pk2(f[4] * sc * g1.x, f[5] * sc * g1.y); w.w = pk2(f[6] * sc * g1.z, f[7] * sc * g1.w);
            drow[ch] = w;
        }
    }
    if (do_rest) for (int it = F.gw * 64 + F.lane; it < (T / 16) * 128; it += F.ngw * 64) {
        const int tile = it >> 7, ch = it & 127, c0 = ch * 8, g = c0 >> 8, w = 2 << g, t0 = tile * 16, s0 = t0 & (SEQ - 1);
        float win[8];
#pragma unroll
        for (int q = 0; q < 8; ++q) win[q] = 0.f;
        const bf16* zc = Z + (size_t)t0 * ZC + ZU + c0;
        {   u32x4 pw[15];
#pragma unroll
            for (int j = 1; j < 16; ++j) { pw[j - 1] = (u32x4){0u, 0u, 0u, 0u}; if (j < w && s0 - j >= 0) pw[j - 1] = *(const u32x4*)(zc - (size_t)j * ZC); }
#pragma unroll
            for (int j = 0; j < 15; ++j) { const u32x4 u = pw[j];
                win[0] += bflo(u.x); win[1] += bfhi(u.x); win[2] += bflo(u.y); win[3] += bfhi(u.y); win[4] += bflo(u.z); win[5] += bfhi(u.z); win[6] += bflo(u.w); win[7] += bfhi(u.w); } }
#pragma unroll
        for (int hh = 0; hh < 2; ++hh) {
            u32x4 uu[8], dd[8];
#pragma unroll
            for (int q = 0; q < 8; ++q) { const int i = hh * 8 + q; uu[q] = *(const u32x4*)(zc + (size_t)i * ZC); dd[q] = (u32x4){0u, 0u, 0u, 0u};
                if (s0 + i - w + 1 >= 0) dd[q] = *(const u32x4*)(zc + (long)(i - w + 1) * (long)ZC); }
#pragma unroll
            for (int q = 0; q < 8; ++q) {
                const int i = hh * 8 + q, s = s0 + i; const u32x4 u = uu[q];
                const float f[8] = {bflo(u.x), bfhi(u.x), bflo(u.y), bfhi(u.y), bflo(u.z), bfhi(u.z), bflo(u.w), bfhi(u.w)};
#pragma unroll
                for (int r = 0; r < 8; ++r) win[r] += f[r];
                const float inv = 1.0f / (float)(s + 1 < w ? s + 1 : w);
                u32x4 o; o.x = pk2(win[0] * inv - f[0], win[1] * inv - f[1]); o.y = pk2(win[2] * inv - f[2], win[3] * inv - f[3]); o.z = pk2(win[4] * inv - f[4], win[5] * inv - f[5]); o.w = pk2(win[6] * inv - f[6], win[7] * inv - f[7]);
                *(u32x4*)(POOLED + (size_t)(t0 + i) * 1024 + c0) = o;
                if (s - w + 1 >= 0) { const u32x4 d = dd[q];
                    win[0] -= bflo(d.x); win[1] -= bfhi(d.x); win[2] -= bflo(d.y); win[3] -= bfhi(d.y); win[4] -= bflo(d.z); win[5] -= bfhi(d.z); win[6] -= bflo(d.w); win[7] -= bfhi(d.w); }
            }
        }
    }
    LAS bf16* scr = (LAS bf16*)(F.lds + F.wave * 9216);
    if (false) for (int it = F.gw; it < 2 * (T / 64) * 16; it += F.ngw) {
        const int which = it / ((T / 64) * 16), r = it % ((T / 64) * 16), tt = r >> 4, cb = r & 15, t0 = tt * 64, c0 = cb * 64;
        const bf16* src = Z + (size_t)t0 * ZC + (which ? ZGV : ZSV) + c0; bf16* dst = which ? GVT : SVT;
#pragma unroll
        for (int j = 0; j < 8; ++j) { const int idx = F.lane + 64 * j, tok = idx >> 3, cc = (idx & 7) * 8; const u32x4 u = *(const u32x4*)(src + (size_t)tok * ZC + cc);
            const unsigned uu[4] = {u.x, u.y, u.z, u.w};
#pragma unroll
            for (int q = 0; q < 4; ++q) { scr[(cc + 2 * q) * 72 + tok] = (bf16)(uu[q] & 0xffffu); scr[(cc + 2 * q + 1) * 72 + tok] = (bf16)(uu[q] >> 16); } }
        LDS_WAIT(); asm volatile("" ::: "memory");
        const int b = t0 / SEQ, s0 = t0 % SEQ;
#pragma unroll
        for (int j = 0; j < 8; ++j) { const int idx = F.lane + 64 * j, chn = idx >> 3, tk = (idx & 7) * 8; const u32x4 u = *(const LAS u32x4*)(scr + chn * 72 + tk);
            *(u32x4*)(dst + ((size_t)(b * 1024 + c0 + chn)) * SEQ + s0 + tk) = u; }
        LDS_WAIT(); asm volatile("" ::: "memory");
    }
}

template <bool GAIN> DI void norm_frag(bf16x8 (&f)[8], int hh, const LAS float* gl) {
    float ss = 0.f;
#pragma unroll
    for (int kk = 0; kk < 8; ++kk) { const u32x4 w = __builtin_bit_cast(u32x4, f[kk]);
        ss += (bflo(w.x) * bflo(w.x) + bfhi(w.x) * bfhi(w.x)) + (bflo(w.y) * bflo(w.y) + bfhi(w.y) * bfhi(w.y)) + (bflo(w.z) * bflo(w.z) + bfhi(w.z) * bfhi(w.z)) + (bflo(w.w) * bflo(w.w) + bfhi(w.w) * bfhi(w.w)); }
    ss += __shfl_xor(ss, 32);
    const float rstd = frsq(ss * (1.0f / 128.0f) + EPS);
#pragma unroll
    for (int kk = 0; kk < 8; ++kk) { f32x4 g0 = (f32x4){rstd, rstd, rstd, rstd}, g1 = g0;
        if constexpr (GAIN) { g0 = *(const LAS f32x4*)(gl + 16 * kk + 8 * hh) * rstd; g1 = *(const LAS f32x4*)(gl + 16 * kk + 8 * hh + 4) * rstd; }
        const u32x4 w = __builtin_bit_cast(u32x4, f[kk]); u32x4 o;
        o.x = pk2(bflo(w.x) * g0.x, bfhi(w.x) * g0.y); o.y = pk2(bflo(w.y) * g0.z, bfhi(w.y) * g0.w); o.z = pk2(bflo(w.z) * g1.x, bfhi(w.z) * g1.y); o.w = pk2(bflo(w.w) * g1.z, bfhi(w.w) * g1.w);
        f[kk] = __builtin_bit_cast(bf16x8, o); asm volatile("" : "+v"(f[kk])); }
}
DI void phase_sb(const Frame& F0, const bf16* Z, const bf16* SVT, bf16* outb, int ldo, int ocol, const float* gq, const float* gk) {
    const Frame F = fresh(F0);
    LAS float* gl = (LAS float*)F.lds;
    if (F.tid < 128) gl[F.tid] = gq[F.tid] * gk[F.tid] * (0.08838834764831845f * LOG2E);
    __syncthreads();
    const int lane = F.lane, tq = lane & 31, hh = lane >> 5;
    const int pi = 16 * ((tq >> 2) & 1) + 4 * (tq >> 3) + (tq & 3);
    for (int u = F.vcu; u < NB * 8 * (SEQ / 256); u += F.G) {
        const int qb = u & 31, bh = u >> 5, b = bh >> 3, h = bh & 7;
        const int t0 = qb * 256 + F.wave * 32;
        const size_t rowbase = (size_t)b * SEQ;
        bf16x8 qf[8];
        { const bf16* qp = Z + (rowbase + t0 + tq) * ZC + ZSQ + h * 128 + hh * 8;
#pragma unroll
          for (int kk = 0; kk < 8; ++kk) qf[kk] = *(const bf16x8*)(qp + kk * 16); }
        norm_frag<true>(qf, hh, gl);
        f32x16 o[4];
#pragma unroll
        for (int db = 0; db < 4; ++db)
#pragma unroll
            for (int r = 0; r < 16; ++r) o[db][r] = 0.f;
        float R = 1.f;
        const bf16* vbase = SVT + ((size_t)(b * 1024 + h * 128 + tq)) * SEQ + 16 * hh;
        for (int s0 = t0; s0 >= 0; s0 -= 32) {
            const bf16* kp = Z + (rowbase + s0 + pi) * ZC + ZSK + h * 128 + hh * 8;
            bf16x8 kf[8];
#pragma unroll
            for (int kk = 0; kk < 8; ++kk) kf[kk] = *(const bf16x8*)(kp + kk * 16);
            bf16x8 vf[4][2];
#pragma unroll
            for (int db = 0; db < 4; ++db)
#pragma unroll
                for (int j = 0; j < 2; ++j) vf[db][j] = *(const bf16x8*)(vbase + (size_t)db * 32 * SEQ + s0 + 8 * j);
            norm_frag<false>(kf, hh, gl);
            f32x16 s;
#pragma unroll
            for (int r = 0; r < 16; ++r) s[r] = 0.f;
#pragma unroll
            for (int kk = 0; kk < 8; ++kk) s = __builtin_amdgcn_mfma_f32_32x32x16_bf16(kf[kk], qf[kk], s, 0, 0, 0);
            const bool diag = (s0 == t0);
            float p[16]; float run = 1.f;
#pragma unroll
            for (int r = 15; r >= 0; --r) {
                const float e = fexp2(s[r]); float keep = frcp(1.0f + e), beta = 1.0f - keep;
                if (diag && (16 * hh + r >= tq)) { keep = 1.0f; beta = 0.f; }
                p[r] = beta * run; run *= keep;
            }
            const float other = __shfl_xor(run, 32);
            const float pref = hh ? R : R * other;
            R = R * run * other;
            bf16x8 pb[2];
#pragma unroll
            for (int j = 0; j < 2; ++j) { u32x4 w; w.x = pk2(p[8 * j] * pref, p[8 * j + 1] * pref); w.y = pk2(p[8 * j + 2] * pref, p[8 * j + 3] * pref); w.z = pk2(p[8 * j + 4] * pref, p[8 * j + 5] * pref); w.w = pk2(p[8 * j + 6] * pref, p[8 * j + 7] * pref);
                pb[j] = __builtin_bit_cast(bf16x8, w); }
#pragma unroll
            for (int db = 0; db < 4; ++db)
#pragma unroll
                for (int j = 0; j < 2; ++j) o[db] = __builtin_amdgcn_mfma_f32_32x32x16_bf16(vf[db][j], pb[j], o[db], 0, 0, 0);
            if (__all(R < 5.9604645e-8f)) break;
        }
        bf16* op = outb + (rowbase + t0 + tq) * ldo + ocol + h * 128 + 4 * hh;
#pragma unroll
        for (int db = 0; db < 4; ++db)
#pragma unroll
            for (int g = 0; g < 4; ++g) { u32x2 w; w.x = pk2(o[db][4 * g], o[db][4 * g + 1]); w.y = pk2(o[db][4 * g + 2], o[db][4 * g + 3]); *(u32x2*)(op + 32 * db + 8 * g) = w; }
    }
}

constexpr int GLA_WLS_OFF = 86016;
DI void gla_stage_wlr(const float* wlr, const float* blr, LAS float* WLS, int tid) {
    for (int i = tid; i < 16 * 512 / 4; i += NTHR) ((LAS f32x4*)WLS)[i] = ((const f32x4*)wlr)[i];
    if (tid < 128) ((LAS f32x4*)(WLS + 16 * 512))[tid] = ((const f32x4*)blr)[tid];
}
DI void gla_unit(int un, int& n, int& b, int& h, size_t& tok0) { n = un & 127; const int bh = un >> 7; b = bh >> 2; h = bh & 3; tok0 = (size_t)b * SEQ + n * 64; }
DI void gla_tile_ld(const bf16* Z, size_t tok0, int col, int tid, u32x4 (&r)[2]) {
#pragma unroll
    for (int j = 0; j < 2; ++j) { const int ch = tid + 512 * j, row = ch >> 4, cc = ch & 15; r[j] = *(const u32x4*)(Z + (tok0 + row) * ZC + col + cc * 8); }
}
DI void gla_tile_st(LAS unsigned char* dst, int tid, const u32x4 (&r)[2]) {
#pragma unroll
    for (int j = 0; j < 2; ++j) { const int ch = tid + 512 * j, row = ch >> 4, cc = ch & 15; *(LAS u32x4*)(dst + row * 272 + cc * 16) = r[j]; }
}
DI u32x4 gla_glr_ld(const bf16* Z, size_t tok0, int tid) { const int row = (tid & 127) >> 1, hf = tid & 1; return *(const u32x4*)(Z + (tok0 + row) * ZC + ZLR + hf * 8); }
DI void gla_glr_st(LAS unsigned char* GL, int tid, const u32x4& r) { if (tid < 128) { const int row = tid >> 1, hf = tid & 1; *(LAS u32x4*)(GL + row * 32 + hf * 16) = r; } }
DI void gla_cum(const LAS unsigned char* GL, const LAS float* WLS, int h, LAS float* part, int tid, float (&bc)[16], float& bend) {
    const int k = tid & 127, tg = tid >> 7;
    float wl[16];
#pragma unroll
    for (int r = 0; r < 16; ++r) wl[r] = WLS[r * 512 + h * 128 + k];
    const float bias = WLS[16 * 512 + h * 128 + k];
    float run = 0.f;
#pragma unroll
    for (int i = 0; i < 16; ++i) {
        const LAS u32x4* gp = (const LAS u32x4*)(GL + (tg * 16 + i) * 32); const u32x4 a = gp[0], c = gp[1];
        float pre = bias;
        pre += bflo(a.x) * wl[0] + bfhi(a.x) * wl[1] + bflo(a.y) * wl[2] + bfhi(a.y) * wl[3] + bflo(a.z) * wl[4] + bfhi(a.z) * wl[5] + bflo(a.w) * wl[6] + bfhi(a.w) * wl[7];
        pre += bflo(c.x) * wl[8] + bfhi(c.x) * wl[9] + bflo(c.y) * wl[10] + bfhi(c.y) * wl[11] + bflo(c.z) * wl[12] + bfhi(c.z) * wl[13] + bflo(c.w) * wl[14] + bfhi(c.w) * wl[15];
        run += flogsigmoid(pre) * (1.0f / 16.0f); bc[i] = run;
    }
    part[tg * 128 + k] = run;
    __syncthreads();
    float off = 0.f, tot = 0.f;
#pragma unroll
    for (int g = 0; g < 4; ++g) { const float pv = part[g * 128 + k]; tot += pv; off += (g < tg) ? pv : 0.f; }
#pragma unroll
    for (int i = 0; i < 16; ++i) bc[i] += off;
    bend = tot;
    __syncthreads();
}
#define MFMA16(a, b, c) __builtin_amdgcn_mfma_f32_16x16x32_bf16((a), (b), (c), 0, 0, 0)
DI void phase_gla1(const Frame& F0, const bf16* Z, const bf16* GVT, const float* wlr, const float* blr, bf16* SBUF, float* DBUF) {
    const Frame F = fresh(F0);
    LAS float* part = (LAS float*)F.lds;
    LAS unsigned char* GL = F.lds + 2048;
    LAS unsigned char* KS = F.lds + 4096;
    LAS unsigned char* KT = KS + 17408;
    const int k = F.tid & 127, tg = F.tid >> 7, l15 = F.lane & 15, l4 = F.lane >> 4;
    int un = blockIdx.x; if (un >= 2048) return;
    int n, b, h; size_t tok0; gla_unit(un, n, b, h, tok0);
    LAS float* WLS = (LAS float*)(F.lds + GLA_WLS_OFF); gla_stage_wlr(wlr, blr, WLS, F.tid);
    u32x4 pk_[2], pg_;
    gla_tile_ld(Z, tok0, ZGK + h * 128, F.tid, pk_); pg_ = gla_glr_ld(Z, tok0, F.tid);
    for (;;) {
        gla_tile_st(KS, F.tid, pk_); gla_glr_st(GL, F.tid, pg_);
        bf16x8 bfr[2][2];
#pragma unroll
        for (int ks = 0; ks < 2; ++ks)
#pragma unroll
            for (int nb = 0; nb < 2; ++nb) bfr[ks][nb] = *(const bf16x8*)(GVT + (size_t)(b * 1024 + h * 256 + 32 * F.wave + 16 * nb + l15) * SEQ + n * 64 + 32 * ks + 8 * l4);
        const int un2 = un + F.G; const bool more = un2 < 2048;
        int n2 = 0, b2 = 0, h2 = 0; size_t tok2 = 0;
        if (more) { gla_unit(un2, n2, b2, h2, tok2); gla_tile_ld(Z, tok2, ZGK + h2 * 128, F.tid, pk_); pg_ = gla_glr_ld(Z, tok2, F.tid); }
        __syncthreads();
        float bc[16], bend; gla_cum(GL, WLS, h, part, F.tid, bc, bend);
        unsigned w[8];
#pragma unroll
        for (int i = 0; i < 8; ++i) {
            const float k0 = bf2f(*(const LAS bf16*)(KS + (tg * 16 + 2 * i) * 272 + k * 2)) * fexp2((bend - bc[2 * i]) * LOG2E);
            const float k1 = bf2f(*(const LAS bf16*)(KS + (tg * 16 + 2 * i + 1) * 272 + k * 2)) * fexp2((bend - bc[2 * i + 1]) * LOG2E);
            w[i] = pk2(k0, k1); }
        *(LAS u32x4*)(KT + k * 144 + tg * 32) = (u32x4){w[0], w[1], w[2], w[3]};
        *(LAS u32x4*)(KT + k * 144 + tg * 32 + 16) = (u32x4){w[4], w[5], w[6], w[7]};
        if (tg == 0) DBUF[(size_t)un * 128 + k] = fexp2(bend * LOG2E);
        __syncthreads();
        f32x4 acc[8][2];
#pragma unroll
        for (int mb = 0; mb < 8; ++mb)
#pragma unroll
            for (int nb = 0; nb < 2; ++nb) acc[mb][nb] = (f32x4){0.f, 0.f, 0.f, 0.f};
#pragma unroll
        for (int ks = 0; ks < 2; ++ks) {
#pragma unroll
            for (int mb = 0; mb < 8; ++mb) { const bf16x8 a = *(const LAS bf16x8*)(KT + (16 * mb + l15) * 144 + (32 * ks + 8 * l4) * 2);
#pragma unroll
                for (int nb = 0; nb < 2; ++nb) acc[mb][nb] = MFMA16(a, bfr[ks][nb], acc[mb][nb]); }
        }
#pragma unroll
        for (int mb = 0; mb < 8; ++mb)
#pragma unroll
            for (int nb = 0; nb < 2; ++nb) { const int dv = 32 * F.wave + 16 * nb + l15; u32x2 o; o.x = pk2(acc[mb][nb].x, acc[mb][nb].y); o.y = pk2(acc[mb][nb].z, acc[mb][nb].w);
                *(u32x2*)(SBUF + ((size_t)un * 256 + dv) * 128 + 16 * mb + 4 * l4) = o; }
        __syncthreads();
        if (!more) break;
        un = un2; n = n2; b = b2; h = h2; tok0 = tok2;
    }
}
DI void phase_gla2(const Frame& F0, const bf16* SBUF, const float* DBUF, bf16* DST) {
    const Frame F = fresh(F0);
    for (int e = blockIdx.x * NTHR + F.tid; e < 16 * 256 * 32; e += F.G * NTHR) {
        const int bh = e >> 13, rem = e & 8191, dv = rem >> 5, k4 = (rem & 31) * 4;
        f32x4 s = (f32x4){0.f, 0.f, 0.f, 0.f};
        const float* dp = DBUF + (size_t)bh * 128 * 128 + k4; const size_t off0 = ((size_t)bh * 128 * 256 + dv) * 128 + k4;
        f32x4 d[8]; u32x2 u[8];
#pragma unroll
        for (int j = 0; j < 8; ++j) { d[j] = *(const f32x4*)(dp + (size_t)j * 128); u[j] = *(const u32x2*)(SBUF + off0 + (size_t)j * 256 * 128); }
        for (int n = 0; n < 128; n += 8) {
            f32x4 dn[8]; u32x2 un_[8];
            const int nn = (n + 8 < 128) ? n + 8 : n;
#pragma unroll
            for (int j = 0; j < 8; ++j) { dn[j] = *(const f32x4*)(dp + (size_t)(nn + j) * 128); un_[j] = *(const u32x2*)(SBUF + off0 + (size_t)(nn + j) * 256 * 128); }
#pragma unroll
            for (int j = 0; j < 8; ++j) {
                s.x = d[j].x * s.x + bflo(u[j].x); s.y = d[j].y * s.y + bfhi(u[j].x); s.z = d[j].z * s.z + bflo(u[j].y); s.w = d[j].w * s.w + bfhi(u[j].y);
                u32x2 o; o.x = pk2(s.x, s.y); o.y = pk2(s.z, s.w); *(u32x2*)(DST + off0 + (size_t)(n + j) * 256 * 128) = o;
            }
#pragma unroll
            for (int j = 0; j < 8; ++j) { d[j] = dn[j]; u[j] = un_[j]; }
        }
    }
}
DI void phase_gla3(const Frame& F0, const bf16* Z, const bf16* GVT, const float* wlr, const float* blr, const float* gout, const bf16* SBUF, bf16* outb, int ldo, int ocol, int mode = 0) {
    const Frame F = fresh(F0);
    LAS float* part = (LAS float*)F.lds;
    LAS float* RS = (LAS float*)(F.lds + 2048);
    LAS unsigned char* GL = F.lds + 4096;
    LAS unsigned char* QS = F.lds + 6144;
    LAS unsigned char* KS = QS + 17408;
    LAS unsigned char* SC = KS + 17408;
    LAS unsigned char* OT = SC + 9216;
    const int k = F.tid & 127, tg = F.tid >> 7, l15 = F.lane & 15, l4 = F.lane >> 4, w = F.wave;
    int un = blockIdx.x; if (un >= 2048) return;
    int n, b, h; size_t tok0; gla_unit(un, n, b, h, tok0);
    LAS float* WLS = (LAS float*)(F.lds + GLA_WLS_OFF); gla_stage_wlr(wlr, blr, WLS, F.tid);
    u32x4 pq_[2], pk_[2], pg_;
    gla_tile_ld(Z, tok0, ZGQ + h * 128, F.tid, pq_); gla_tile_ld(Z, tok0, ZGK + h * 128, F.tid, pk_); pg_ = gla_glr_ld(Z, tok0, F.tid);
    for (;;) {
        gla_tile_st(QS, F.tid, pq_); gla_tile_st(KS, F.tid, pk_); gla_glr_st(GL, F.tid, pg_);
        bf16x8 fs[4][2], fv[2][2]; u32x4 grc[4];
#pragma unroll
        for (int ks = 0; ks < 4; ++ks)
#pragma unroll
            for (int mb = 0; mb < 2; ++mb) fs[ks][mb] = *(const bf16x8*)(SBUF + ((size_t)(n > 0 ? un - 1 : un) * 256 + 32 * w + 16 * mb + l15) * 128 + 32 * ks + 8 * l4);
#pragma unroll
        for (int ks = 0; ks < 2; ++ks)
#pragma unroll
            for (int mb = 0; mb < 2; ++mb) fv[ks][mb] = *(const bf16x8*)(GVT + (size_t)(b * 1024 + h * 256 + 32 * w + 16 * mb + l15) * SEQ + n * 64 + 32 * ks + 8 * l4);
#pragma unroll
        for (int j = 0; j < 4; ++j) { const int ch = F.tid + 512 * j; grc[j] = *(const u32x4*)(Z + (tok0 + (ch >> 5)) * ZC + ZGR + h * 256 + (ch & 31) * 8); }
        const int un2 = un + F.G; const bool more = un2 < 2048;
        int n2 = 0, b2 = 0, h2 = 0; size_t tok2 = 0;
        if (more) { gla_unit(un2, n2, b2, h2, tok2); gla_tile_ld(Z, tok2, ZGQ + h2 * 128, F.tid, pq_); gla_tile_ld(Z, tok2, ZGK + h2 * 128, F.tid, pk_); pg_ = gla_glr_ld(Z, tok2, F.tid); }
        __syncthreads();
        float bc[16], bend; gla_cum(GL, WLS, h, part, F.tid, bc, bend);
#pragma unroll
        for (int i = 0; i < 16; ++i) {
            LAS bf16* qp = (LAS bf16*)(QS + (tg * 16 + i) * 272 + k * 2); LAS bf16* kp = (LAS bf16*)(KS + (tg * 16 + i) * 272 + k * 2);
            const float qv = bf2f(*qp) * 0.08838834764831845f * fexp2(bc[i] * LOG2E), kv = bf2f(*kp) * fexp2(-bc[i] * LOG2E);
            *qp = (bf16)(pk2(qv, 0.f) & 0xffffu); *kp = (bf16)(pk2(kv, 0.f) & 0xffffu);
        }
        __syncthreads();
        if (mode == 1) { if (!more) break; un = un2; n = n2; b = b2; h = h2; tok0 = tok2; continue; }
        {
            const int mb = w >> 1;
#pragma unroll
            for (int q = 0; q < 2; ++q) {
                const int nb = 2 * (w & 1) + q;
                f32x4 sc = (f32x4){0.f, 0.f, 0.f, 0.f};
                if (mb <= nb) {
#pragma unroll
                    for (int ks = 0; ks < 4; ++ks) { const bf16x8 a = *(const LAS bf16x8*)(KS + (16 * mb + l15) * 272 + (32 * ks + 8 * l4) * 2), bq = *(const LAS bf16x8*)(QS + (16 * nb + l15) * 272 + (32 * ks + 8 * l4) * 2);
                        sc = MFMA16(a, bq, sc); } }
                const int t = 16 * nb + l15, s_ = 16 * mb + 4 * l4;
                const float v0 = (s_ + 0 <= t) ? sc.x : 0.f, v1 = (s_ + 1 <= t) ? sc.y : 0.f, v2 = (s_ + 2 <= t) ? sc.z : 0.f, v3 = (s_ + 3 <= t) ? sc.w : 0.f;
                u32x2 o; o.x = pk2(v0, v1); o.y = pk2(v2, v3); *(LAS u32x2*)(SC + t * 144 + s_ * 2) = o;
            }
        }
        __syncthreads();
        if (mode == 2) { if (!more) break; un = un2; n = n2; b = b2; h = h2; tok0 = tok2; continue; }
        f32x4 acc[2][4];
#pragma unroll
        for (int mb = 0; mb < 2; ++mb)
#pragma unroll
            for (int nb = 0; nb < 4; ++nb) acc[mb][nb] = (f32x4){0.f, 0.f, 0.f, 0.f};
        if (n > 0) {
#pragma unroll
            for (int ks = 0; ks < 4; ++ks) {
                bf16x8 bq[4];
#pragma unroll
                for (int nb = 0; nb < 4; ++nb) bq[nb] = *(const LAS bf16x8*)(QS + (16 * nb + l15) * 272 + (32 * ks + 8 * l4) * 2);
#pragma unroll
                for (int mb = 0; mb < 2; ++mb)
#pragma unroll
                    for (int nb = 0; nb < 4; ++nb) acc[mb][nb] = MFMA16(fs[ks][mb], bq[nb], acc[mb][nb]);
            }
        }
#pragma unroll
        for (int ks = 0; ks < 2; ++ks) {
            bf16x8 bq[4];
#pragma unroll
            for (int nb = 0; nb < 4; ++nb) bq[nb] = *(const LAS bf16x8*)(SC + (16 * nb + l15) * 144 + (32 * ks + 8 * l4) * 2);
#pragma unroll
            for (int mb = 0; mb < 2; ++mb)
#pragma unroll
                for (int nb = 0; nb < 4; ++nb) acc[mb][nb] = MFMA16(fv[ks][mb], bq[nb], acc[mb][nb]);
        }
        if (mode == 3) { if (acc[0][0].x == 12345.678f) outb[0] = 0; __syncthreads(); if (!more) break; un = un2; n = n2; b = b2; h = h2; tok0 = tok2; continue; }
#pragma unroll
        for (int nb = 0; nb < 4; ++nb) {
            float ss = 0.f;
#pragma unroll
            for (int mb = 0; mb < 2; ++mb) { const f32x4 a = acc[mb][nb]; ss += (a.x * a.x + a.y * a.y) + (a.z * a.z + a.w * a.w);
                u32x2 o; o.x = pk2(a.x, a.y); o.y = pk2(a.z, a.w); *(LAS u32x2*)(OT + (16 * nb + l15) * 528 + (32 * w + 16 * mb + 4 * l4) * 2) = o; }
            ss += __shfl_xor(ss, 16); ss += __shfl_xor(ss, 32);
            if (l4 == 0) RS[w * 64 + 16 * nb + l15] = ss;
        }
        __syncthreads();
#pragma unroll
        for (int j = 0; j < 4; ++j) {
            const int ch = F.tid + 512 * j, t = ch >> 5, dv0 = (ch & 31) * 8;
            float tot = 0.f;
#pragma unroll
            for (int ww = 0; ww < 8; ++ww) tot += RS[ww * 64 + t];
            const float rstd = frsq(tot * (1.0f / 256.0f) + EPS);
            const u32x4 ov = *(const LAS u32x4*)(OT + t * 528 + dv0 * 2), gr = grc[j];
            const f32x4 g0 = *(const f32x4*)(gout + dv0), g1 = *(const f32x4*)(gout + dv0 + 4);
            f32x4 o0, o1, r0, r1; unpack8(ov, o0, o1); unpack8(gr, r0, r1);
            o0 = o0 * rstd * g0 * (f32x4){fsilu(r0.x), fsilu(r0.y), fsilu(r0.z), fsilu(r0.w)}; o1 = o1 * rstd * g1 * (f32x4){fsilu(r1.x), fsilu(r1.y), fsilu(r1.z), fsilu(r1.w)};
            *(u32x4*)(outb + (tok0 + t) * ldo + ocol + h * 256 + dv0) = pack8(o0, o1);
        }
        __syncthreads();
        if (!more) break;
        un = un2; n = n2; b = b2; h = h2; tok0 = tok2;
    }
}

DI void phase_moe_pos(const Frame& F0, const int* sel, const float* selw, const int* cnt, int* slot, float* roww, int* tile_e, int* rowtok) {
    const Frame F = fresh(F0);
    const int c = blockIdx.x, tid = F.tid;
    LAS int* s_sel = (LAS int*)F.lds; LAS int* s_tot = s_sel + 128; LAS int* s_bef = s_tot + 8; LAS int* s_off = s_bef + 8; LAS int* s_base = s_off + 8; LAS int* s_wc = s_base + 8;
    if (tid < 128) s_sel[tid] = sel[c * 128 + tid];
    if (tid < 16) s_tot[tid] = 0;
    __syncthreads();
    {
        const i32x4 v = ((const i32x4*)cnt)[tid]; const bool bf = (tid >> 1) < c;
        int t0 = v.x, t1 = v.y, t2 = v.z, t3 = v.w, b0 = bf ? v.x : 0, b1 = bf ? v.y : 0, b2 = bf ? v.z : 0, b3 = bf ? v.w : 0;
#pragma unroll
        for (int o = 2; o < 64; o <<= 1) { t0 += __shfl_xor(t0, o); t1 += __shfl_xor(t1, o); t2 += __shfl_xor(t2, o); t3 += __shfl_xor(t3, o); b0 += __shfl_xor(b0, o); b1 += __shfl_xor(b1, o); b2 += __shfl_xor(b2, o); b3 += __shfl_xor(b3, o); }
        if (F.lane < 2) { const int e0 = F.lane * 4; atomicAdd((int*)(s_tot + e0), t0); atomicAdd((int*)(s_tot + e0 + 1), t1); atomicAdd((int*)(s_tot + e0 + 2), t2); atomicAdd((int*)(s_tot + e0 + 3), t3);
            atomicAdd((int*)(s_bef + e0), b0); atomicAdd((int*)(s_bef + e0 + 1), b1); atomicAdd((int*)(s_bef + e0 + 2), b2); atomicAdd((int*)(s_bef + e0 + 3), b3); }
    }
    int e_i = 0, rank = 0;
    if (tid < 256) {
        const int sv = s_sel[tid >> 1]; e_i = (tid & 1) ? (sv >> 8) : (sv & 255);
#pragma unroll
        for (int e = 0; e < NE; ++e) { const unsigned long long m = __ballot(e_i == e); if (e_i == e) rank = __popcll(m & ((1ull << F.lane) - 1ull)); if (F.lane == 0) s_wc[F.wave * 8 + e] = __popcll(m); }
    }
    __syncthreads();
    if (tid == 0) {
        int base = 0;
        for (int e = 0; e < NE; ++e) { s_base[e] = base; s_off[e] = base + s_bef[e]; const int nt = (s_tot[e] + 255) >> 8; if (c == 0) for (int t = 0; t < nt; ++t) tile_e[1 + (base >> 8) + t] = e; base += nt * 256; }
        if (c == 0) tile_e[0] = base >> 8;
    }
    __syncthreads();
    if (tid < 256) {
        int pre = 0; for (int w = 0; w < F.wave; ++w) pre += s_wc[w * 8 + e_i];
        const int pos = s_off[e_i] + pre + rank, tok = c * 128 + (tid >> 1);
        slot[2 * tok + (tid & 1)] = pos; roww[pos] = selw[2 * tok + (tid & 1)]; rowtok[pos] = tok;
    }
    if (c == 0) for (int e = 0; e < NE; ++e) { const int tot = s_tot[e], pad = ((tot + 255) >> 8) << 8; for (int r = tot + tid; r < pad; r += NTHR) rowtok[s_base[e] + r] = 0; }
}
DI void phase_moe_combine(const Frame& F0, const int* slot, const bf16* YSORT, bf16* X, bf16* HB) {
    const Frame F = fresh(F0);
    for (int m = F.gw; m < T; m += F.ngw) {
        const int p0 = slot[2 * m], p1 = slot[2 * m + 1];
        u32x2 xr[8]; int ya[8], yb[8];
#pragma unroll
        for (int j = 0; j < 8; ++j) { const int idx = F.lane + 64 * j; xr[j] = ((const u32x2*)(X + (size_t)m * D))[idx];
            ya[j] = ((const int*)((const unsigned char*)YSORT + (size_t)p0 * D))[idx]; yb[j] = ((const int*)((const unsigned char*)YSORT + (size_t)p1 * D))[idx]; }
#pragma unroll
        for (int j = 0; j < 8; ++j) { const int idx = F.lane + 64 * j; const u32x2 xw = xr[j]; f32x4 x = (f32x4){bflo(xw.x), bfhi(xw.x), bflo(xw.y), bfhi(xw.y)};
            const int y0 = ya[j], y1 = yb[j];
            const f32x2 a0 = __builtin_amdgcn_cvt_pk_f32_fp8(y0, false), a1 = __builtin_amdgcn_cvt_pk_f32_fp8(y0, true), b0 = __builtin_amdgcn_cvt_pk_f32_fp8(y1, false), b1 = __builtin_amdgcn_cvt_pk_f32_fp8(y1, true);
            x.x += (a0.x + b0.x) * 0.0625f; x.y += (a0.y + b0.y) * 0.0625f; x.z += (a1.x + b1.x) * 0.0625f; x.w += (a1.y + b1.y) * 0.0625f;
            u32x2 ow; ow.x = pk2(x.x, x.y); ow.y = pk2(x.z, x.w); ((u32x2*)(X + (size_t)m * D))[idx] = ow; ((unsigned*)((unsigned char*)HB + (size_t)m * D))[idx] = pk4_fp8(x.x, x.y, x.z, x.w); }
    }
}

using pg8::Unit;
typedef f32x4 AccT[2][2][4][2];
constexpr float GATE_TINY = 8.673617379884035e-19f;
struct PBase { pg8::StaticOrder so; int K, lda, ldb; };
DI unsigned pk4_u8(const f32x4& g) { const float a = fmaxf(__builtin_floorf(g.x * 255.0f + 0.5f), 1.0f), b = fmaxf(__builtin_floorf(g.y * 255.0f + 0.5f), 1.0f), c = fmaxf(__builtin_floorf(g.z * 255.0f + 0.5f), 1.0f), d = fmaxf(__builtin_floorf(g.w * 255.0f + 0.5f), 1.0f);
    unsigned w = 0; w = __builtin_amdgcn_cvt_pk_u8_f32(a, 0, w); w = __builtin_amdgcn_cvt_pk_u8_f32(b, 1, w); w = __builtin_amdgcn_cvt_pk_u8_f32(c, 2, w); w = __builtin_amdgcn_cvt_pk_u8_f32(d, 3, w); return w; }
DI f32x4 u8x4_f(unsigned w) { return (f32x4){(float)(w & 0xffu), (float)((w >> 8) & 0xffu), (float)((w >> 16) & 0xffu), (float)(w >> 24)}; }
DI f32x4 exp2_4(const f32x4& v) { return (f32x4){fexp2(v.x), fexp2(v.y), fexp2(v.z), fexp2(v.w)}; }
DI f32x4 max4(const f32x4& v, float m) { return (f32x4){fmaxf(v.x, m), fmaxf(v.y, m), fmaxf(v.z, m), fmaxf(v.w, m)}; }
DI f32x4 rcp4(const f32x4& v) { return (f32x4){frcp(v.x), frcp(v.y), frcp(v.z), frcp(v.w)}; }
DI f32x4 sig4(const f32x4& v) { return rcp4(exp2_4(v * (-LOG2E)) + 1.0f); }
DI f32x4 swi4(const f32x4& a, const f32x4& b) { return a * sig4(a) * b; }

DI void touch_lines(const char* base, size_t pitch_bytes, int lpr_shift, int nlines, int wid, int lane, LAS unsigned char* lds) {
    for (int i = wid * 64 + lane; i < nlines; i += 512) { const int row = i >> lpr_shift, seg = i & ((1 << lpr_shift) - 1);
        __builtin_amdgcn_global_load_lds((const unsigned*)(base + (size_t)row * pitch_bytes + seg * 128), (LAS unsigned*)(lds + JUNK_OFF + wid * 256), 4, 0, 0); }
}
DI float rstd_of(const unsigned long long* ssq, int row) { return ssq ? frsq((float)ssq[row] * (SSQ_UNFIX / D) + EPS) : 1.0f; }
struct PIn : PBase {
    static constexpr bool PERM = true, FP8 = false, PREFETCH = false, SWAPMM = false, GATHER = false; static constexpr int BSCALE = 0x7f7f7f7f;
    const bf16* A; const bf16* Bt; bf16* Zo; const unsigned long long* ssq;
    DI static int ztile(int pn) { return pn < 12 ? pn : (pn < 16 ? pn + 4 : pn + 8); }
    DI bool next(int i, Unit& u) const { u.aux = 0; return so.tile(i, u.pm, u.pn); }
    DI const char* a_base(const Unit& u) const { return (const char*)(A + (size_t)u.pm * 256 * lda); }
    DI const char* b_base(const Unit& u) const { return (const char*)(Bt + (size_t)ztile(u.pn) * 256 * ldb); }
    DI bool epi(AccT& acc, const Unit& u, int wr, int wc, int fr, int fq) const {
        const int row0 = u.pm * 256 + wr * 64 + fr, col0 = ztile(u.pn) * 256 + wc * 32 + 8 * fq;
        float rs[2][4];
#pragma unroll
        for (int ai = 0; ai < 2; ++ai)
#pragma unroll
            for (int m = 0; m < 4; ++m) rs[ai][m] = rstd_of(ssq, row0 + ai * 128 + m * 16);
#pragma unroll
        for (int ai = 0; ai < 2; ++ai)
#pragma unroll
            for (int m = 0; m < 4; ++m) { bf16* rowp = Zo + (size_t)(row0 + ai * 128 + m * 16) * ZC + col0;
#pragma unroll
                for (int bj = 0; bj < 2; ++bj) *(u32x4*)(rowp + bj * 128) = pack8(acc[ai][bj][m][0] * rs[ai][m], acc[ai][bj][m][1] * rs[ai][m]);
                asm volatile("" ::: "memory"); }
        return true;
    }
};
struct PInVT : PBase {
    static constexpr bool PERM = false, FP8 = false, PREFETCH = false, SWAPMM = true, GATHER = false; static constexpr int BSCALE = 0x7f7f7f7f;
    const bf16* A; const bf16* Bt; bf16* SVTo; bf16* GVTo; const unsigned long long* ssq;
    DI bool next(int i, Unit& u) const { u.aux = 0; return so.tile(i, u.pm, u.pn); }
    DI const char* a_base(const Unit& u) const { return (const char*)(A + (size_t)u.pm * 256 * lda); }
    DI const char* b_base(const Unit& u) const { return (const char*)(Bt + (size_t)(u.pn < 4 ? 12 + u.pn : 16 + u.pn) * 256 * ldb); }
    DI bool epi(AccT& acc, const Unit& u, int wr, int wc, int fr, int fq) const {
        bf16* dst = u.pn < 4 ? SVTo : GVTo;
        const int b = (u.pm * 256) / SEQ, s0 = (u.pm * 256) % SEQ + wr * 64 + 4 * fq, ch0 = (u.pn & 3) * 256 + wc * 32 + fr;
        f32x4 rs[2][4];
#pragma unroll
        for (int ai = 0; ai < 2; ++ai)
#pragma unroll
            for (int m = 0; m < 4; ++m) { const int t0 = u.pm * 256 + wr * 64 + 4 * fq + ai * 128 + m * 16;
                rs[ai][m] = (f32x4){rstd_of(ssq, t0), rstd_of(ssq, t0 + 1), rstd_of(ssq, t0 + 2), rstd_of(ssq, t0 + 3)}; }
#pragma unroll
        for (int bj = 0; bj < 2; ++bj)
#pragma unroll
            for (int n = 0; n < 2; ++n) { bf16* rowp = dst + ((size_t)(b * 1024 + ch0 + bj * 128 + n * 16)) * SEQ + s0;
#pragma unroll
                for (int ai = 0; ai < 2; ++ai)
#pragma unroll
                    for (int m = 0; m < 4; ++m) { const f32x4 a = acc[ai][bj][m][n] * rs[ai][m]; u32x2 o; o.x = pk2(a.x, a.y); o.y = pk2(a.z, a.w); *(u32x2*)(rowp + ai * 128 + m * 16) = o; }
                asm volatile("" ::: "memory"); }
        return true;
    }
};
struct PGates : PBase {
    static constexpr bool PERM = true, FP8 = true, PREFETCH = false, SWAPMM = false, GATHER = false; static constexpr int BSCALE = 0x79797979;
    const bf16* A; const bf16* Bt; bf16* Go; const float* bias; const unsigned long long* ssq;
    DI bool next(int i, Unit& u) const { u.aux = 0; return so.tile(i, u.pm, u.pn); }
    DI const char* a_base(const Unit& u) const { return (const char*)(A + (size_t)u.pm * 256 * lda); }
    DI const char* b_base(const Unit& u) const { return (const char*)(Bt + (size_t)u.pn * 256 * ldb); }
    DI bool epi(AccT& acc, const Unit& u, int wr, int wc, int fr, int fq) const {
        const int row0 = u.pm * 256 + wr * 64 + fr, col0 = u.pn * 256 + wc * 32 + 8 * fq;
        f32x4 bv[2][2];
#pragma unroll
        for (int bj = 0; bj < 2; ++bj)
#pragma unroll
            for (int n = 0; n < 2; ++n) bv[bj][n] = *(const f32x4*)(bias + col0 + bj * 128 + 4 * n);
        float rs[2][4];
#pragma unroll
        for (int ai = 0; ai < 2; ++ai)
#pragma unroll
            for (int m = 0; m < 4; ++m) rs[ai][m] = rstd_of(ssq, row0 + ai * 128 + m * 16);
#pragma unroll
        for (int ai = 0; ai < 2; ++ai)
#pragma unroll
            for (int m = 0; m < 4; ++m) { unsigned char* rowp = (unsigned char*)Go + (size_t)(row0 + ai * 128 + m * 16) * GC + col0;
#pragma unroll
                for (int bj = 0; bj < 2; ++bj) { u32x2 o; o.x = pk4_u8(sig4(acc[ai][bj][m][0] * rs[ai][m] + bv[bj][0])); o.y = pk4_u8(sig4(acc[ai][bj][m][1] * rs[ai][m] + bv[bj][1])); *(u32x2*)(rowp + bj * 128) = o; }
                asm volatile("" ::: "memory"); }
        return true;
    }
};
struct PPool : PBase {
    static constexpr bool PERM = true, FP8 = false, PREFETCH = false, SWAPMM = false, GATHER = false; static constexpr int BSCALE = 0x7f7f7f7f;
    const bf16* A; const bf16* Bt; bf16* Zo; const float* scale;
    DI bool next(int i, Unit& u) const { u.aux = 0; return so.tile(i, u.pm, u.pn); }
    DI const char* a_base(const Unit& u) const { return (const char*)(A + (size_t)u.pm * 256 * 1024 + u.pn * 256); }
    DI const char* b_base(const Unit& u) const { return (const char*)(Bt + (size_t)u.pn * 256 * 256); }
    DI bool epi(AccT& acc, const Unit& u, int wr, int wc, int fr, int fq) const {
        const int row0 = u.pm * 256 + wr * 64 + fr, col0 = u.pn * 256 + wc * 32 + 8 * fq;
        f32x4 sv[2][2];
#pragma unroll
        for (int bj = 0; bj < 2; ++bj)
#pragma unroll
            for (int n = 0; n < 2; ++n) sv[bj][n] = *(const f32x4*)(scale + col0 + bj * 128 + 4 * n);
#pragma unroll
        for (int ai = 0; ai < 2; ++ai)
#pragma unroll
            for (int m = 0; m < 4; ++m) { bf16* rowp = Zo + (size_t)(row0 + ai * 128 + m * 16) * ZC + ZU + col0;
#pragma unroll
                for (int bj = 0; bj < 2; ++bj) *(u32x4*)(rowp + bj * 128) = pack8(acc[ai][bj][m][0] * sv[bj][0], acc[ai][bj][m][1] * sv[bj][1]);
                asm volatile("" ::: "memory"); }
        return true;
    }
};
struct PUp : PBase {
    static constexpr bool PERM = true, FP8 = false, PREFETCH = false, SWAPMM = false, GATHER = false; static constexpr int BSCALE = 0x7f7f7f7f;
    const bf16* Zi; const bf16* Wup; const bf16* Gi; bf16* Mo;
    DI bool next(int i, Unit& u) const { u.aux = i % 3; return so.tile(i / 3, u.pm, u.pn); }
    DI const char* a_base(const Unit& u) const { return (const char*)(Zi + (size_t)u.pm * 256 * ZC + (u.aux == 0 ? ZU : (u.aux == 1 ? ZSQ : ZGR))); }
    DI const char* b_base(const Unit& u) const { return (const char*)(Wup + (size_t)u.aux * 2048 * 1024 + (size_t)u.pn * 256 * 1024); }
    DI void pre_epi(const Unit& u, int wid, int lane, LAS unsigned char* lds) const {
        touch_lines((const char*)(Gi + (size_t)u.pm * 256 * GC + u.aux * 2048 + u.pn * 256), (size_t)GC * 2, 2, 1024, wid, lane, lds);
        if (u.aux < 2) touch_lines((const char*)(Gi + (size_t)u.pm * 256 * GC + (u.aux + 1) * 2048 + u.pn * 256), (size_t)GC * 2, 2, 1024, wid, lane, lds);
    }
    DI bool epi(AccT& acc, const Unit& u, int wr, int wc, int fr, int fq) const {
        const int row0 = u.pm * 256 + wr * 64 + fr, col0 = u.pn * 256 + wc * 32 + 8 * fq;
        const bool lastb = (u.aux == 2);
        const unsigned char* gbase = (const unsigned char*)Gi + (size_t)row0 * GC + u.aux * 2048 + col0; const int noff = lastb ? 0 : 2048;
        u32x2 cur[4], nxt[4], nx2[4];
#define PUP_LOAD(dst, g) do { const unsigned char* gp_ = gbase + (size_t)(((g) >> 2) * 128 + ((g) & 3) * 16) * GC; \
            dst[0] = *(const u32x2*)(gp_); dst[1] = *(const u32x2*)(gp_ + 128); dst[2] = *(const u32x2*)(gp_ + noff); dst[3] = *(const u32x2*)(gp_ + noff + 128); } while (0)
        PUP_LOAD(cur, 0); PUP_LOAD(nxt, 1);
#pragma unroll
        for (int g = 0; g < 8; ++g) {
            const int ai = g >> 2, m = g & 3;
            if (g < 6) PUP_LOAD(nx2, g + 2);
            bf16* op = Mo + (size_t)(row0 + ai * 128 + m * 16) * D + col0;
#pragma unroll
            for (int bj = 0; bj < 2; ++bj) { const f32x4 c0 = u8x4_f(cur[bj].x), c1 = u8x4_f(cur[bj].y), n0 = u8x4_f(cur[2 + bj].x), n1 = u8x4_f(cur[2 + bj].y);
                f32x4 r0 = rcp4(n0), r1 = rcp4(n1);
                if (lastb) { r0 = (f32x4){1.f / 255.f, 1.f / 255.f, 1.f / 255.f, 1.f / 255.f}; r1 = r0; }
                acc[ai][bj][m][0] = acc[ai][bj][m][0] * (c0 * r0); acc[ai][bj][m][1] = acc[ai][bj][m][1] * (c1 * r1);
                if (lastb) *(u32x4*)(op + bj * 128) = pack8(acc[ai][bj][m][0], acc[ai][bj][m][1]); }
#pragma unroll
            for (int q = 0; q < 4; ++q) { cur[q] = nxt[q]; nxt[q] = nx2[q]; }
        }
#undef PUP_LOAD
        return lastb;
    }
};
template <int MODE, bool FP8_ = false> struct PResid : PBase {
    static constexpr bool PERM = false, FP8 = FP8_, PREFETCH = false, SWAPMM = false, GATHER = false; static constexpr int BSCALE = FP8_ ? 0x79797979 : 0x7f7f7f7f;
    const bf16* A; const bf16* Bt; bf16* X; bf16* XB; const bf16* PPi; float* OUT; bool fin; unsigned long long* ssq; unsigned char* X8;
    DI bool next(int i, Unit& u) const { u.aux = 0; return so.tile(i, u.pm, u.pn); }
    DI const char* a_base(const Unit& u) const { return (const char*)(A + (size_t)u.pm * 256 * lda); }
    DI const char* b_base(const Unit& u) const { return (const char*)(Bt + (size_t)u.pn * 256 * ldb); }
    DI void pre_epi(const Unit& u, int wid, int lane, LAS unsigned char* lds) const {
        touch_lines((const char*)(X + (size_t)u.pm * 256 * D + u.pn * 256), (size_t)D * 2, 2, 1024, wid, lane, lds);
        if (MODE == 2) touch_lines((const char*)(PPi + (size_t)u.pm * 256 * D + u.pn * 256), (size_t)D * 2, 2, 1024, wid, lane, lds);
    }
    DI bool epi(AccT& acc, const Unit& u, int wr, int wc, int fr, int fq) const {
        const int row0 = u.pm * 256 + wr * 64 + fr, col0 = u.pn * 256 + wc * 32 + 4 * fq;
        u32x2 cx[2][2], nx[2][2], cp[2][2], np_[2][2], fx[2][2], fp_[2][2];
#define PR_LOAD(dx, dp, g) do { const size_t off_ = (size_t)(row0 + ((g) >> 2) * 128 + ((g) & 3) * 16) * D + col0; \
            _Pragma("unroll") for (int bj = 0; bj < 2; ++bj) _Pragma("unroll") for (int n = 0; n < 2; ++n) { dx[bj][n] = *(const u32x2*)(X + off_ + bj * 128 + n * 16); if (MODE == 2) dp[bj][n] = *(const u32x2*)(PPi + off_ + bj * 128 + n * 16); } } while (0)
        PR_LOAD(cx, cp, 0); PR_LOAD(nx, np_, 1);
#pragma unroll
        for (int g = 0; g < 8; ++g) {
            const int ai = g >> 2, m = g & 3; const size_t off = (size_t)(row0 + ai * 128 + m * 16) * D + col0;
            if (g < 6) PR_LOAD(fx, fp_, g + 2);
            float gss = 0.f;
#pragma unroll
            for (int bj = 0; bj < 2; ++bj)
#pragma unroll
                for (int n = 0; n < 2; ++n) { f32x4 a = acc[ai][bj][m][n];
                    if (MODE == 2) { const u32x2 w = cp[bj][n]; a = sig4(a) * (f32x4){bflo(w.x), bfhi(w.x), bflo(w.y), bfhi(w.y)}; }
                    const u32x2 xw = cx[bj][n]; const f32x4 x = (f32x4){bflo(xw.x), bfhi(xw.x), bflo(xw.y), bfhi(xw.y)} + a;
                    if (fin) *(f32x4*)(OUT + off + bj * 128 + n * 16) = x; else { u32x2 ow; ow.x = pk2(x.x, x.y); ow.y = pk2(x.z, x.w); *(u32x2*)(X + off + bj * 128 + n * 16) = ow;
                        if (ssq) { const float r0 = bflo(ow.x), r1 = bfhi(ow.x), r2 = bflo(ow.y), r3 = bfhi(ow.y); gss += (r0 * r0 + r1 * r1) + (r2 * r2 + r3 * r3); }
                        if (X8) *(unsigned*)(X8 + off + bj * 128 + n * 16) = pk4_fp8(x.x, x.y, x.z, x.w); }
                    if (MODE == 1) *(unsigned*)((unsigned char*)XB + off + bj * 128 + n * 16) = pk4_fp8(x.x, x.y, x.z, x.w); }
            if (ssq) {
                gss += __shfl_xor(gss, 16); gss += __shfl_xor(gss, 32);
                if (fq == 0) (void)__hip_atomic_fetch_add(ssq + row0 + ai * 128 + m * 16, (unsigned long long)(gss * SSQ_FIX + 0.5f), __ATOMIC_RELAXED, __HIP_MEMORY_SCOPE_AGENT); }
#pragma unroll
            for (int bj = 0; bj < 2; ++bj)
#pragma unroll
                for (int n = 0; n < 2; ++n) { cx[bj][n] = nx[bj][n]; nx[bj][n] = fx[bj][n]; if (MODE == 2) { cp[bj][n] = np_[bj][n]; np_[bj][n] = fp_[bj][n]; } }
        }
#undef PR_LOAD
        return true;
    }
};
template <bool GROUPED, bool F8 = true, bool OUT8 = F8> struct PSwiglu : PBase {
    static constexpr bool PERM = true, FP8 = F8, PREFETCH = false, SWAPMM = false, GATHER = GROUPED; static constexpr int BSCALE = F8 ? 0x79797979 : 0x7f7f7f7f;
    const unsigned char* A; const unsigned char* Bt; unsigned char* O; const int* tile_e; const int* rowtok; const unsigned long long* ssq;
    DI bool next(int i, Unit& u) const { const bool ok = so.tile(i, u.pm, u.pn); u.aux = (GROUPED && ok) ? tile_e[1 + u.pm] : 0; return ok; }
    DI const char* a_base(const Unit& u) const { return GROUPED ? (const char*)A : (const char*)(A + (size_t)u.pm * 256 * lda * 2); }
    DI unsigned row_off(const Unit& u, int r) const { return (unsigned)rowtok[u.pm * 256 + r] * (unsigned)(lda * 2); }
    DI const char* b_base(const Unit& u) const { return (const char*)(Bt + (size_t)u.aux * WMOE_E + (size_t)u.pn * 256 * ldb * 2); }
    DI bool epi(AccT& acc, const Unit& u, int wr, int wc, int fr, int fq) const {
        const int row0 = u.pm * 256 + wr * 64 + fr, col0 = u.pn * 128 + wc * 32 + 8 * fq;
#pragma unroll
        for (int ai = 0; ai < 2; ++ai)
#pragma unroll
            for (int m = 0; m < 4; ++m) { const float rs = GROUPED ? 1.0f : rstd_of(ssq, row0 + ai * 128 + m * 16);
                const f32x4 v0 = swi4(acc[ai][0][m][0] * rs, acc[ai][1][m][0] * rs), v1 = swi4(acc[ai][0][m][1] * rs, acc[ai][1][m][1] * rs);
                if constexpr (OUT8) { u32x2 o; o.x = pk4_fp8(v0.x, v0.y, v0.z, v0.w); o.y = pk4_fp8(v1.x, v1.y, v1.z, v1.w); *(u32x2*)(O + (size_t)(row0 + ai * 128 + m * 16) * DFF + col0) = o; }
                else *(u32x4*)((bf16*)O + (size_t)(row0 + ai * 128 + m * 16) * DFF + col0) = pack8(v0, v1);
                asm volatile("" ::: "memory"); }
        return true;
    }
};
template <bool GROUPED, bool FP8_ = false> struct PBf16 : PBase {
    static constexpr bool PERM = true, FP8 = FP8_, PREFETCH = false, SWAPMM = false, GATHER = false; static constexpr int BSCALE = FP8_ ? 0x79797979 : 0x7f7f7f7f;
    const bf16* A; const unsigned char* Bt; bf16* O; int ldo; const int* tile_e; const float* rw;
    DI bool next(int i, Unit& u) const { const bool ok = so.tile(i, u.pm, u.pn); u.aux = (GROUPED && ok) ? tile_e[1 + u.pm] : 0; return ok; }
    DI const char* a_base(const Unit& u) const { return (const char*)(A + (size_t)u.pm * 256 * lda); }
    DI const char* b_base(const Unit& u) const { return (const char*)(Bt + (size_t)u.aux * WMOE_E + (size_t)u.pn * 256 * ldb * 2); }
    DI bool epi(AccT& acc, const Unit& u, int wr, int wc, int fr, int fq) const {
        const int row0 = u.pm * 256 + wr * 64 + fr, col0 = u.pn * 256 + wc * 32 + 8 * fq;
        float sw[2][4];
#pragma unroll
        for (int ai = 0; ai < 2; ++ai)
#pragma unroll
            for (int m = 0; m < 4; ++m) sw[ai][m] = GROUPED ? rw[row0 + ai * 128 + m * 16] : 1.0f;
#pragma unroll
        for (int ai = 0; ai < 2; ++ai)
#pragma unroll
            for (int m = 0; m < 4; ++m) { const int r = row0 + ai * 128 + m * 16; const float s = sw[ai][m]; bf16* rowp = O + (size_t)r * ldo + col0;
#pragma unroll
                for (int bj = 0; bj < 2; ++bj) {
                    if constexpr (GROUPED) { const f32x4 a = acc[ai][bj][m][0] * (16.0f * s), b = acc[ai][bj][m][1] * (16.0f * s);
                        u32x2 o; o.x = pk4_fp8(a.x, a.y, a.z, a.w); o.y = pk4_fp8(b.x, b.y, b.z, b.w); *(u32x2*)((unsigned char*)O + (size_t)r * ldo + col0 + bj * 128) = o; }
                    else *(u32x4*)(rowp + bj * 128) = pack8(acc[ai][bj][m][0] * s, acc[ai][bj][m][1] * s); }
                asm volatile("" ::: "memory"); }
        return true;
    }
};

constexpr int PH_PER_LAYER = 18, NPH = 1 + 2 * PH_PER_LAYER;
typedef const Args __attribute__((address_space(4)))* ArgP;
DI ArgP argp() { unsigned long long p = (unsigned long long)__builtin_amdgcn_kernarg_segment_ptr(); asm volatile("" : "+s"(p)); return (ArgP)p; }
#define AIN(k) (argp()->in[k])
__global__ void __launch_bounds__(NTHR, 2) fwd(Args args_unused) {
    extern __shared__ __attribute__((aligned(16))) unsigned char lds_raw[];
    Frame F;
    F.lds = (LAS unsigned char*)lds_raw;
    F.tid = threadIdx.x; F.lane = F.tid & 63; F.wave = __builtin_amdgcn_readfirstlane(F.tid >> 6);
    F.G = gridDim.x; { const int bx = blockIdx.x; F.vcu = (F.G % 8 == 0) ? (bx % 8) * (F.G / 8) + bx / 8 : bx; }
    F.gw = F.vcu * NWAVES + F.wave; F.ngw = F.G * NWAVES;
    volatile LAS unsigned* MISC = (volatile LAS unsigned*)(F.lds + MISC_OFF);
    if (F.tid < 16) MISC[F.tid] = 0u;
    __syncthreads();
    unsigned char* ws = argp()->ws;
    unsigned* ctl = (unsigned*)(ws + WS_CTL);
    const int lo = argp()->ph_lo, hi = argp()->ph_hi;
    XcdBarrier bar; bar.bar = ctl + CW_BAR; bar.x = 0; bar.st = MISC + 8;
    if (hi - lo > 1) bar = xcd_barrier_post(ctl + CW_BAR, MISC + 8);
#ifndef ONLY_SITE
#define ONLY_SITE -1
#endif
#ifndef ONLY_SUB
#define ONLY_SUB -1
#endif
#define SITE_ON(k) (ONLY_SITE < 0 || ONLY_SITE == (k))
#define SUB_ON(k) (ONLY_SUB < 0 || ONLY_SUB == (k))
#define IN(k) (lo <= (k) && (k) < hi)
#define SEAM(k) do { if ((k) + 1 < hi || DBG_TIME_MASK != 0ull || FP8_SELFTEST) xcd_barrier(bar); if (DBG_TIME_MASK != 0ull && blockIdx.x == 0 && threadIdx.x == 0) ((unsigned long long*)(ctl + 32768))[(k) + 1] = __builtin_amdgcn_s_memrealtime(); } while (0)
    bf16* X = (bf16*)(ws + WS_END);
    float* OUTF = argp()->out;

#if FP8_SELFTEST
    if (lo == 0 && blockIdx.x == 0 && F.wave == 0) {
        typedef int i32x8 __attribute__((ext_vector_type(8)));
        const int l = F.lane, i = l & 15, g = l >> 4;
        i32x8 a, b;
#pragma unroll
        for (int d = 0; d < 8; ++d) {
            float av[4], bv[4];
#pragma unroll
            for (int q = 0; q < 4; ++q) { const int k = 32 * g + 4 * d + q; av[q] = (float)(((i * 7 + k * 3) % 5) - 2); bv[q] = (float)(((k * 5 + i * 11) % 7) - 3); }
            int wa = 0, wb = 0;
            wa = __builtin_amdgcn_cvt_pk_fp8_f32(av[0], av[1], wa, false); wa = __builtin_amdgcn_cvt_pk_fp8_f32(av[2], av[3], wa, true);
            wb = __builtin_amdgcn_cvt_pk_fp8_f32(bv[0], bv[1], wb, false); wb = __builtin_amdgcn_cvt_pk_fp8_f32(bv[2], bv[3], wb, true);
            a[d] = wa; b[d] = wb;
        }
        f32x4 c1 = (f32x4){0.f, 0.f, 0.f, 0.f}, c2 = c1;
        c1 = __builtin_amdgcn_mfma_scale_f32_16x16x128_f8f6f4(a, b, c1, 0, 0, 0, 0x7f7f7f7f, 0, 0x7f7f7f7f);
        c2 = __builtin_amdgcn_mfma_scale_f32_16x16x128_f8f6f4(a, b, c2, 0, 0, 0, 0x7f7f7f7f, 0, 0x79797979);
        bool ok = true;
#pragma unroll
        for (int q = 0; q < 4; ++q) { const int r = 4 * g + q; float ref = 0.f;
            for (int k = 0; k < 128; ++k) ref += (float)(((r * 7 + k * 3) % 5) - 2) * (float)(((k * 5 + i * 11) % 7) - 3);
            ok = ok && fabsf(c1[q] - ref) < 0.25f && fabsf(c2[q] * 64.0f - ref) < 0.25f; }
        const bool all_ok = __all(ok);
        if (l == 0) ctl[40000] = all_ok ? 1u : 2u;
    }
#endif
    if (DBG_TIME_MASK != 0ull && blockIdx.x == 0 && threadIdx.x == 0) ((unsigned long long*)(ctl + 32768))[0] = __builtin_amdgcn_s_memrealtime();
    bf16* HB = (bf16*)(ws + WS_HB); bf16* PP = (bf16*)(ws + WS_PP); bf16* Z = (bf16*)(ws + WS_Z); bf16* GATES = (bf16*)(ws + WS_GATES);
    bf16* POOLED = (bf16*)(ws + WS_POOLED); bf16* SVT = (bf16*)(ws + WS_SVT); bf16* GVT = (bf16*)(ws + WS_GVT); bf16* SBUF = (bf16*)(ws + WS_SBUF);
    float* DBUF = (float*)(ws + WS_DBUF);
    int* SEL = (int*)(ws + WS_MISC + MISC_SEL); float* SELW = (float*)(ws + WS_MISC + MISC_SELW); int* SLOT = (int*)(ws + WS_MISC + MISC_SLOT); int* CNT = (int*)(ws + WS_MISC + MISC_CNT);
    float* ROWW = (float*)(ws + WS_MISC + MISC_ROWW); int* TILE_E = (int*)(ws + WS_MISC + MISC_TILE);
    const int c = (int)blockIdx.x;

    if (SITE_ON(100) && IN(0)) {
        for (int rep = 0; rep < ((DUP_MASK & 2) ? 2 : 1); ++rep) {
        int rot = 0;
        for (int L = 0; L < 2; ++L) {
            unsigned char* wl = ws + WS_W + (size_t)L * WL_SIZE;
            const float* gfold = (L == 1) ? AIN(I_GMIX) + D : nullptr;
            convert_matrix(F, AIN(I_WIN) + (size_t)L * D * IN_COLS, D, IN_COLS, (bf16*)(wl + WL_WIN), 1, 0, rot, -1, gfold); rot += 32 * 225;
            convert_matrix<true>(F, AIN(I_WBG) + (size_t)L * D * GC, D, GC, (bf16*)(wl + WL_WBG8), 0, 0, rot, -1, gfold); rot += 32 * 192;
            for (int g = 0; g < 4; ++g) { convert_matrix(F, AIN(I_POOLW) + (size_t)(L * 4 + g) * 65536, 256, 256, (bf16*)(wl + WL_POOL) + g * 65536, 0, 0, rot); rot += 32; }
            convert_matrix(F, AIN(I_WUPP) + (size_t)L * 1024 * D, 1024, D, (bf16*)(wl + WL_WUP), 0, 0, rot); rot += 16 * 64;
            convert_matrix(F, AIN(I_WUPS) + (size_t)L * 1024 * D, 1024, D, (bf16*)(wl + WL_WUP) + (size_t)1 * D * 1024, 0, 0, rot); rot += 16 * 64;
            convert_matrix(F, AIN(I_WUPG) + (size_t)L * 1024 * D, 1024, D, (bf16*)(wl + WL_WUP) + (size_t)2 * D * 1024, 0, 0, rot); rot += 16 * 64;
            convert_matrix(F, AIN(I_WO) + (size_t)L * D * D, D, D, (bf16*)(wl + WL_WO), 0, 0, rot); rot += 32 * 64;
            convert_matrix(F, AIN(I_PLEP) + (size_t)L * PLE * D, PLE, D, (bf16*)(wl + WL_PLEP), 0, 0, rot); rot += 4 * 64;
            convert_matrix<true>(F, AIN(I_PLEG) + (size_t)L * D * D, D, D, (bf16*)(wl + WL_PLEG), 0, 0, rot); rot += 32 * 64;
        }
        convert_matrix<DENSE_FP8 != 0>(F, AIN(I_FW1), D, DFF, (bf16*)(ws + WS_FFN13), 2, 0, rot, -1, AIN(I_GFFN)); rot += 32 * 176;
        convert_matrix<DENSE_FP8 != 0>(F, AIN(I_FW3), D, DFF, (bf16*)(ws + WS_FFN13), 3, 0, rot, -1, AIN(I_GFFN)); rot += 32 * 176;
        convert_matrix<(DENSE_FP8 != 0) || (DENSE2_FP8 != 0)>(F, AIN(I_FW2), DFF, D, (bf16*)(ws + WS_FFN2), 0, 0, rot);
        }
        {
            const f32x4* src = (const f32x4*)AIN(I_P); u32x4* dst = (u32x4*)(ws + WS_PB);
            for (size_t i = (size_t)blockIdx.x * NTHR + F.tid; i < (size_t)2 * T * PLE / 8; i += (size_t)F.G * NTHR) dst[i] = pack8(src[2 * i], src[2 * i + 1]);
        }
        SEAM(0);
    }

#pragma clang loop unroll(full)
    for (int L = 0; L < 2; ++L) {
        const int pb = 1 + L * PH_PER_LAYER;
        unsigned char* wl = ws + WS_W + (size_t)L * WL_SIZE;
        if (SITE_ON(0) && IN(pb + 0)) { if (L == 0) phase_rmsnorm<false, false>(F, AIN(I_X), AIN(I_GMIX), HB, X, ws + WS_PP);
            if (L == 0) SEAM(pb + 0); }
        if (SITE_ON(1) && IN(pb + 1)) {
            const unsigned long long* ssq1 = (L == 0) ? nullptr : (const unsigned long long*)(ws + WS_CTL + CTL_SS1); const bf16* Ain = (L == 0) ? HB : X; const bf16* Ain8 = (const bf16*)(L == 0 ? ws + WS_PP : ws + WS_POOLED);
            { PIn P; P.so.init(T / 256, 21, F.G, c); P.K = D; P.lda = D; P.ldb = D; P.A = Ain; P.Bt = (const bf16*)(wl + WL_WIN); P.Zo = Z; P.ssq = ssq1;
              pg8::gemm_phase(F.lds, P); if ((DUP_MASK & 64) && L == 1) pg8::gemm_phase(F.lds, P); }
            { PInVT P; P.so.init(T / 256, 8, F.G, c); P.K = D; P.lda = D; P.ldb = D; P.A = Ain; P.Bt = (const bf16*)(wl + WL_WIN); P.SVTo = SVT; P.GVTo = GVT; P.ssq = ssq1;
              pg8::gemm_phase(F.lds, P); }
            { PGates P; P.so.init(T / 256, GC / 256, F.G, c); P.K = D / 2; P.lda = D / 2; P.ldb = D / 2; P.A = Ain8; P.Bt = (const bf16*)(wl + WL_WBG8); P.Go = GATES; P.bias = AIN(I_BBG) + L * GC; P.ssq = ssq1;
              pg8::gemm_phase(F.lds, P); }
            SEAM(pb + 1);
        }
        if (SITE_ON(2) && IN(pb + 2)) {             phase_postproj(F, Z, AIN(I_SBGQ) + L * 128, AIN(I_SBGK) + L * 128, POOLED, SVT, GVT, false, true, Z + ZSQ, ZC);
            if ((DUP_MASK & 8) && L == 1) { __syncthreads(); phase_postproj(F, Z, AIN(I_SBGQ) + L * 128, AIN(I_SBGK) + L * 128, POOLED, SVT, GVT, false, true, Z + ZSQ, ZC); }
            SEAM(pb + 2); }
        if (SITE_ON(3) && IN(pb + 3)) {
            if (SUB_ON(0)) { PPool P; P.so.init(T / 256, 4, F.G, c); P.K = 256; P.lda = 1024; P.ldb = 256; P.A = POOLED; P.Bt = (const bf16*)(wl + WL_POOL); P.Zo = Z; P.scale = AIN(I_POOLS) + L * 1024;
              pg8::gemm_phase(F.lds, P); if ((DUP_MASK & 128) && L == 1) pg8::gemm_phase(F.lds, P); }
            if (SUB_ON(1)) { PBf16<false> P; P.so.init(T / 256, D / 256, F.G, c); P.K = PLE; P.lda = PLE; P.ldb = PLE; P.A = (const bf16*)(ws + WS_PB) + (size_t)L * T * PLE; P.Bt = wl + WL_PLEP; P.O = PP; P.ldo = D; P.tile_e = nullptr; P.rw = nullptr;
              pg8::gemm_phase(F.lds, P); if ((DUP_MASK & 128) && L == 1) pg8::gemm_phase(F.lds, P); }
            __syncthreads();
            if ((DUP_MASK & 2048) && L == 1) phase_sb(F, Z, SVT, POOLED, 1024, 0, AIN(I_SBGQ) + L * 128, AIN(I_SBGK) + L * 128);
            if (SUB_ON(2)) phase_sb(F, Z, SVT, Z, ZC, ZSQ, AIN(I_SBGQ) + L * 128, AIN(I_SBGK) + L * 128);
            __syncthreads();
            if (SUB_ON(3)) phase_gla1(F, Z, GVT, AIN(I_GLAWLR) + L * 16 * 512, AIN(I_GLABLR) + L * 512, SBUF, DBUF);
            if ((DUP_MASK & 16) && L == 1) phase_gla1(F, Z, GVT, AIN(I_GLAWLR) + L * 16 * 512, AIN(I_GLABLR) + L * 512, SBUF, DBUF);
            SEAM(pb + 3);
        }
        if (SITE_ON(4) && IN(pb + 4)) { phase_gla2(F, SBUF, DBUF, SBUF); SEAM(pb + 4); }
        if (SITE_ON(5) && IN(pb + 5)) { if ((DUP_MASK & 8192) && L == 1) phase_gla3(F, Z, GVT, AIN(I_GLAWLR) + L * 16 * 512, AIN(I_GLABLR) + L * 512, AIN(I_GLAGOUT) + L * 256, SBUF, POOLED, 1024, 0, G3_DUP_MODE);
            phase_gla3(F, Z, GVT, AIN(I_GLAWLR) + L * 16 * 512, AIN(I_GLABLR) + L * 512, AIN(I_GLAGOUT) + L * 256, SBUF, Z, ZC, ZGR); SEAM(pb + 5); }
        if (SITE_ON(6) && IN(pb + 6)) {
            PUp P; P.so.init(T / 256, D / 256, F.G, c); P.K = 1024; P.lda = ZC; P.ldb = 1024; P.Zi = Z; P.Wup = (const bf16*)(wl + WL_WUP); P.Gi = GATES; P.Mo = HB;
            pg8::gemm_phase(F.lds, P); if ((DUP_MASK & 1024) && L == 1) pg8::gemm_phase(F.lds, P); SEAM(pb + 6);
        }
        if (SITE_ON(7) && IN(pb + 7)) {
            PResid<0> P; P.so.init(T / 256, D / 256, F.G, c); P.K = D; P.lda = D; P.ldb = D; P.A = HB; P.Bt = (const bf16*)(wl + WL_WO); P.X = X; P.XB = nullptr; P.PPi = nullptr; P.OUT = nullptr; P.fin = false; P.ssq = (L == 0) ? (unsigned long long*)(ws + WS_CTL + CTL_SS0) : nullptr; P.X8 = nullptr;
            pg8::gemm_phase(F.lds, P); SEAM(pb + 7);
        }
        if (SITE_ON(8) && IN(pb + 8)) {
            if (L == 1) {
                phase_rmsnorm_route(F, X, AIN(I_GFFN) + L * D, HB, AIN(I_ROUTER), SEL, SELW, CNT, AIN(I_MW1), AIN(I_MW3), AIN(I_MW2), ws + WS_WMOE);
                SEAM(pb + 8);
            }
        }
        if (L == 0) {
            if (SITE_ON(9) && IN(pb + 9)) {
                constexpr int DV = DENSE_FP8 ? 2 : 1;
                PSwiglu<false, DENSE_FP8 != 0, (DENSE_FP8 != 0) || (DENSE2_FP8 != 0)> P; P.so.init(T / 256, DFF / 128, F.G, c); P.K = D / DV; P.lda = D / DV; P.ldb = D / DV; P.A = (const unsigned char*)X; P.Bt = ws + WS_FFN13; P.O = ws + WS_ACT; P.tile_e = nullptr; P.rowtok = nullptr; P.ssq = (const unsigned long long*)(ws + WS_CTL + CTL_SS0);
                pg8::gemm_phase(F.lds, P); if (DUP_MASK & 1) pg8::gemm_phase(F.lds, P); SEAM(pb + 9);
            }
            if (SITE_ON(10) && IN(pb + 10)) {
                constexpr int DV = (DENSE_FP8 || DENSE2_FP8) ? 2 : 1;
                PResid<1, (DENSE_FP8 != 0) || (DENSE2_FP8 != 0)> P; P.so.init(T / 256, D / 256, F.G, c); P.K = DFF / DV; P.lda = DFF / DV; P.ldb = DFF / DV; P.A = (const bf16*)(ws + WS_ACT); P.Bt = (const bf16*)(ws + WS_FFN2); P.X = X; P.XB = HB; P.PPi = nullptr; P.OUT = nullptr; P.fin = false; P.ssq = nullptr; P.X8 = nullptr;
                pg8::gemm_phase(F.lds, P); SEAM(pb + 10);
            }
        } else {
            const int kb = pb + 9;
            int* ROWTOK = (int*)(ws + WS_MISC + MISC_ROWTOK);
            if (SITE_ON(11) && IN(kb + 0)) { phase_moe_pos(F, SEL, SELW, CNT, SLOT, ROWW, TILE_E, ROWTOK); SEAM(kb + 0); }
            if (SITE_ON(12) && IN(kb + 1)) {
                const int ntiles = TILE_E[0];
                PSwiglu<true> P; P.so.init(ntiles, DFF / 128, F.G, c); P.K = D / 2; P.lda = D / 2; P.ldb = D / 2; P.A = (const unsigned char*)HB; P.Bt = ws + WS_WMOE; P.O = ws + WS_ACTS; P.tile_e = TILE_E; P.rowtok = ROWTOK; P.ssq = nullptr;
                pg8::gemm_phase(F.lds, P); if (DUP_MASK & 256) pg8::gemm_phase(F.lds, P); SEAM(kb + 1);
            }
            if (SITE_ON(13) && IN(kb + 2)) {
                const int ntiles = TILE_E[0];
                PBf16<true, true> P; P.so.init(ntiles, D / 256, F.G, c); P.K = DFF / 2; P.lda = DFF / 2; P.ldb = DFF / 2; P.A = (const bf16*)(ws + WS_ACTS); P.Bt = ws + WS_WMOE + WMOE_W2; P.O = (bf16*)(ws + WS_YSORT); P.ldo = D;
                P.tile_e = TILE_E; P.rw = ROWW;
                pg8::gemm_phase(F.lds, P); if (DUP_MASK & 512) pg8::gemm_phase(F.lds, P); SEAM(kb + 2);
            }
            if (SITE_ON(14) && IN(kb + 3)) { phase_moe_combine(F, SLOT, (const bf16*)(ws + WS_YSORT), X, HB); SEAM(kb + 3); }
        }
        if (SITE_ON(17) && IN(pb + 17)) {
            PResid<2, true> P; P.so.init(T / 256, D / 256, F.G, c); P.K = D / 2; P.lda = D / 2; P.ldb = D / 2; P.A = HB; P.Bt = (const bf16*)(wl + WL_PLEG); P.X = X; P.XB = nullptr; P.PPi = PP; P.OUT = OUTF; P.fin = (L == 1); P.ssq = (L == 0) ? (unsigned long long*)(ws + WS_CTL + CTL_SS1) : nullptr; P.X8 = (L == 0) ? ws + WS_POOLED : nullptr;
            pg8::gemm_phase(F.lds, P); SEAM(pb + 17);
        }
    }
#if FP8_SELFTEST
    if (blockIdx.x == 0 && threadIdx.x == 0 && ctl[40000] != 1u) OUTF[0] = 1000.0f;
#endif
    if (DBG_TIME_MASK != 0ull && blockIdx.x == 0 && threadIdx.x == 0) {
        const unsigned long long* st = (const unsigned long long*)(ctl + 32768); unsigned long long prev = st[0], sum = 0ull;
        for (int k = 0; k < NPH; ++k) { const unsigned long long e = st[k + 1]; if (e != 0ull) { if ((DBG_TIME_MASK >> k) & 1ull) sum += e - prev; prev = e; } }
        OUTF[0] = (float)sum * DBG_TIME_SCALE;
    }
#undef IN
#undef SEAM
}

extern "C" void kernel_launch(void* const* d_in, const int* in_sizes, int n_in, void* d_out, int out_size, void* d_ws, size_t ws_size, hipStream_t stream) {
    static int grid = 0;
    if (grid == 0) {
        if (n_in != 27 || in_sizes[0] != T * D || out_size != T * D || ws_size < WS_END + 128 * MiB) { fprintf(stderr, "kernel_launch: shape/workspace mismatch (n_in %d, in0 %d, out %d, ws %zu < %zu)\n", n_in, n_in > 0 ? in_sizes[0] : -1, out_size, ws_size, (size_t)WS_END); grid = -1; return; }
        int dev = 0, cus = 0, per_cu = 0;
        if (hipGetDevice(&dev) != hipSuccess || hipDeviceGetAttribute(&cus, hipDeviceAttributeMultiprocessorCount, dev) != hipSuccess) { grid = -1; return; }
        if (hipFuncSetAttribute((const void*)fwd, hipFuncAttributeMaxDynamicSharedMemorySize, LDS_BYTES) != hipSuccess) { fprintf(stderr, "kernel_launch: hipFuncSetAttribute failed\n"); grid = -1; return; }
        if (hipOccupancyMaxActiveBlocksPerMultiprocessor(&per_cu, (const void*)fwd, NTHR, LDS_BYTES) != hipSuccess || per_cu < 1) { fprintf(stderr, "kernel_launch: occupancy query says %d blocks per CU\n", per_cu); }
        (void)hipGetLastError();
        if (cus < 256) { fprintf(stderr, "kernel_launch: needs >= 256 CUs (got %d)\n", cus); grid = -1; return; }
        grid = 256;
    }
    if (grid < 0) return;
    (void)hipMemsetAsync((char*)d_ws + WS_CTL, 0, CTL_ZERO_BYTES, stream);
    Args a{};
    for (int i = 0; i < 27; ++i) a.in[i] = (const float*)d_in[i];
    a.out = (float*)d_out; a.ws = (unsigned char*)d_ws;
#if MK_PER_PHASE
    for (int ph = 0; ph < NPH; ++ph) {
        if ((ph >= 1 + 11 && ph <= 1 + 16) || (ph >= 19 + 13 && ph <= 19 + 16)) continue;
        a.ph_lo = ph; a.ph_hi = ph + 1;
        hipLaunchKernelGGL(fwd, dim3(grid), dim3(NTHR), LDS_BYTES, stream, a);
    }
#else
    a.ph_lo = 0; a.ph_hi = NPH;
    hipLaunchKernelGGL(fwd, dim3(grid), dim3(NTHR), LDS_BYTES, stream, a);
#endif
    const hipError_t le = hipPeekAtLastError();
    if (le != hipSuccess) fprintf(stderr, "kernel_launch: launch failed: %s\n", hipGetErrorName(le));
}
```
